# Optimizing an MI355X kernel written in HIP

```python
import math
import jax, jax.numpy as jnp
from jax import lax
import numpy as np

D_MODEL = 1024
BATCH = 16
SEQ = 256
DEPTH = 1
DEC_BATCH = 2
DEC_SEQ = 4096
PAST_LEN = 256

GRID_W = 64
D_MIX = D_MODEL
N_DIR = 2
D_RWKV = D_MIX // 2
HEAD_DIM = 64
N_RWKV_HEADS = D_RWKV // HEAD_DIM
DECAY_LORA = 64
ICLR_LORA = 64
GATE_LORA = 128
D_SSM = D_MIX - D_RWKV
SSM_GROUP = 16
N_SSM_GROUPS = D_SSM // SSM_GROUP
SSM_STATE = 64
D_FF = 4 * D_MODEL
N_MOD = 6
RMS_EPS = 1e-6
GN_EPS = 64e-5
OFF_R = 0
OFF_K = OFF_R + D_RWKV
OFF_V = OFF_K + D_RWKV
OFF_WD = OFF_V + D_RWKV
OFF_AD = OFF_WD + N_DIR * DECAY_LORA
OFF_GD = OFF_AD + N_DIR * ICLR_LORA
OFF_U = OFF_GD + GATE_LORA
D_IN_PROJ = OFF_U + D_SSM

kernel_name = "hybrid_rwkv7_s5_flow_step"


def rms_norm(x, g):
    x32 = x.astype(jnp.float32)
    y = x32 * lax.rsqrt(jnp.mean(x32 * x32, axis=-1, keepdims=True) + RMS_EPS)
    return (y * g.astype(jnp.float32)).astype(x.dtype)


def grid_pos_embed(n_tok, d):
    rows = n_tok // GRID_W
    nf = d // 4
    omega = 1.0 / (10000.0 ** (jnp.arange(nf, dtype=jnp.float32) / nf))
    ang_r = jnp.arange(rows, dtype=jnp.float32)[:, None] * omega
    ang_c = jnp.arange(GRID_W, dtype=jnp.float32)[:, None] * omega
    e_r = jnp.concatenate([jnp.sin(ang_r), jnp.cos(ang_r)], axis=-1)
    e_c = jnp.concatenate([jnp.sin(ang_c), jnp.cos(ang_c)], axis=-1)
    pe = jnp.concatenate([jnp.broadcast_to(e_r[:, None], (rows, GRID_W, d // 2)),
                          jnp.broadcast_to(e_c[None], (rows, GRID_W, d // 2))], axis=-1)
    return pe.reshape(rows * GRID_W, d)


def _heads(x):
    return x.reshape(x.shape[:-1] + (N_RWKV_HEADS, HEAD_DIM))


def rwkv7_mix(z, s0, decay_base, w_decay_up, iclr_base, w_iclr_up, w_gate_up,
              k_k, k_a, r_k, lnx_g, lnx_b):
    f32 = jnp.float32
    bsz, t = z.shape[0], z.shape[1]
    zf = z.astype(f32)
    r = zf[..., OFF_R:OFF_K]
    k = zf[..., OFF_K:OFF_V]
    v = zf[..., OFF_V:OFF_WD]
    wd = zf[..., OFF_WD:OFF_AD].reshape(bsz, t, N_DIR, DECAY_LORA)
    ad = zf[..., OFF_AD:OFF_GD].reshape(bsz, t, N_DIR, ICLR_LORA)
    gd = zf[..., OFF_GD:OFF_U]
    logw = -jax.nn.softplus(-(decay_base.astype(f32)
                              + jnp.einsum('btdr,drc->btdc', jnp.tanh(wd), w_decay_up.astype(f32)))) - 0.5
    w = jnp.exp(-jnp.exp(logw))
    a = jax.nn.sigmoid(iclr_base.astype(f32)
                       + jnp.einsum('btdr,drc->btdc', ad, w_iclr_up.astype(f32)))
    g = jax.nn.sigmoid(gd) @ w_gate_up.astype(f32)
    kk = _heads(k * k_k.astype(f32))
    kk = (kk / jnp.maximum(jnp.linalg.norm(kk, axis=-1, keepdims=True), 1e-12)).reshape(bsz, t, D_RWKV)
    k_dir = k[:, :, None] * (1.0 + (a - 1.0) * k_a.astype(f32))
    b_dir = kk[:, :, None] * a

    def two(x):
        return jnp.broadcast_to(x[:, :, None], (bsz, t, N_DIR, D_RWKV))

    def seq(x):
        x = jnp.stack([x[:, :, 0], jnp.flip(x[:, :, 1], axis=1)], axis=0)
        return jnp.moveaxis(_heads(x), 2, 0)

    xs = (seq(two(r)), seq(w), seq(k_dir), seq(two(v)), seq(two(-kk)), seq(b_dir))

    def step(S, inp):
        r_t, w_t, k_t, v_t, ma_t, b_t = inp
        sa = jnp.einsum('dbhij,dbhj->dbhi', S, ma_t)
        S = S * w_t[..., None, :] + sa[..., None] * b_t[..., None, :] + v_t[..., None] * k_t[..., None, :]
        return S, jnp.einsum('dbhij,dbhj->dbhi', S, r_t)

    s_last, ys = lax.scan(step, jnp.moveaxis(s0.astype(f32), 1, 0), xs)
    y = jnp.moveaxis(ys[:, 0] + jnp.flip(ys[:, 1], axis=0), 0, 1)
    mu = jnp.mean(y, axis=-1, keepdims=True)
    var = jnp.mean(jnp.square(y - mu), axis=-1, keepdims=True)
    y = ((y - mu) * lax.rsqrt(var + GN_EPS)).reshape(bsz, t, D_RWKV) * lnx_g.astype(f32) + lnx_b.astype(f32)
    bonus = jnp.sum(_heads(r) * _heads(k) * r_k.astype(f32), axis=-1, keepdims=True) * _heads(v)
    y = (y + bonus.reshape(bsz, t, D_RWKV)) * g
    return y.astype(z.dtype), jnp.moveaxis(s_last, 0, 1)


def s5_mix(u, h0_re, h0_im, lam_re, lam_im, log_dt, b_re, b_im, c_re, c_im, d_skip, w_glu, b_glu):
    f32 = jnp.float32
    bsz, t = u.shape[0], u.shape[1]
    uf = u.astype(f32)
    ug = uf.reshape(bsz, t, N_SSM_GROUPS, SSM_GROUP)
    lam = lax.complex(lam_re.astype(f32), lam_im.astype(f32))
    dt = jnp.exp(log_dt.astype(f32))
    lam_dt = lam[None] * dt[..., None]
    lam_bar = jnp.exp(lam_dt)
    b_mat = lax.complex(b_re.astype(f32), b_im.astype(f32))
    b_bar = ((lam_bar - 1.0) / lam[None])[..., None] * b_mat
    bu = jnp.einsum('dgph,btgh->dbtgp', b_bar, ug)
    bu = jnp.stack([bu[0], jnp.flip(bu[1], axis=1)], axis=0)
    a_el = jnp.broadcast_to(lam_bar[:, None, None], (N_DIR, 1, t, N_SSM_GROUPS, SSM_STATE))

    def combine(e1, e2):
        a1, x1 = e1
        a2, x2 = e2
        return a2 * a1, a2 * x1 + x2

    _, h = lax.associative_scan(combine, (a_el, bu), axis=2)
    h0 = jnp.moveaxis(lax.complex(h0_re.astype(f32), h0_im.astype(f32)), 1, 0)
    tpos = jnp.arange(1, t + 1, dtype=f32)
    decay_pow = jnp.exp(lam_dt[:, None] * tpos[None, :, None, None])
    h = h + decay_pow[:, None] * h0[:, :, None]
    h_last = jnp.moveaxis(h[:, :, -1], 0, 1)
    c_mat = lax.complex(c_re.astype(f32), c_im.astype(f32))
    y = jnp.real(jnp.einsum('dghp,dbtgp->dbtgh', c_mat, h))
    y = (y[0] + jnp.flip(y[1], axis=1)).reshape(bsz, t, D_SSM) + d_skip.astype(f32) * uf
    y = jax.nn.gelu(y)
    y = y * jax.nn.sigmoid(y @ w_glu.astype(f32) + b_glu.astype(f32))
    return y.astype(u.dtype), jnp.real(h_last), jnp.imag(h_last)


def trunk_layer(x, cond, st_rwkv, st_re, st_im, lp):
    mod = jax.nn.silu(cond) @ lp['w_ada'] + lp['b_ada']
    sh1, sc1, g1, sh2, sc2, g2 = jnp.split(mod[:, None, :], N_MOD, axis=-1)
    h = rms_norm(x, lp['norm1_g']) * (1.0 + sc1) + sh1
    z = h @ lp['w_in']
    y_r, s_r = rwkv7_mix(z, st_rwkv, lp['decay_base'], lp['w_decay_up'], lp['iclr_base'],
                         lp['w_iclr_up'], lp['w_gate_up'], lp['k_k'], lp['k_a'], lp['r_k'],
                         lp['lnx_g'], lp['lnx_b'])
    y_s, s_re, s_im = s5_mix(z[..., OFF_U:], st_re, st_im, lp['ssm_lambda_re'], lp['ssm_lambda_im'],
                             lp['ssm_log_dt'], lp['ssm_b_re'], lp['ssm_b_im'], lp['ssm_c_re'],
                             lp['ssm_c_im'], lp['ssm_d'], lp['w_glu'], lp['b_glu'])
    x = x + g1 * (jnp.concatenate([y_r, y_s], axis=-1) @ lp['w_out'])
    h = rms_norm(x, lp['norm2_g']) * (1.0 + sc2) + sh2
    x = x + g2 * (jnp.square(jax.nn.relu(h @ lp['w_ff1'])) @ lp['w_ff2'])
    return x, s_r, s_re, s_im


def setup_inputs(seed: int = 0) -> dict:
    key = jax.random.key(seed)
    ks = iter(jax.random.split(key, 48))

    def nrm(shape, scale):
        return jax.random.normal(next(ks), shape, jnp.float32) * scale

    L = DEPTH
    lam_im_base = jnp.broadcast_to(math.pi * jnp.arange(SSM_STATE, dtype=jnp.float32),
                                   (L, N_SSM_GROUPS, SSM_STATE))
    return {
        'x_prompt': nrm((BATCH, SEQ, D_MODEL), 1.0),
        'x_sample': nrm((DEC_BATCH, DEC_SEQ, D_MODEL), 1.0),
        'c': nrm((DEC_BATCH, D_MODEL), 1.0),
        'c_ctx': nrm((D_MODEL,), 1.0),
        'state_rwkv': nrm((DEC_BATCH, L, N_DIR, N_RWKV_HEADS, HEAD_DIM, HEAD_DIM), 0.3),
        'state_ssm_re': nrm((DEC_BATCH, L, N_DIR, N_SSM_GROUPS, SSM_STATE), 0.5),
        'state_ssm_im': nrm((DEC_BATCH, L, N_DIR, N_SSM_GROUPS, SSM_STATE), 0.5),
        'norm1_g': 1.0 + nrm((L, D_MODEL), 0.05),
        'norm2_g': 1.0 + nrm((L, D_MODEL), 0.05),
        'w_ada': nrm((L, D_MODEL, N_MOD * D_MODEL), 0.5 * D_MODEL ** -0.5),
        'b_ada': nrm((L, N_MOD * D_MODEL), 0.01),
        'w_in': nrm((L, D_MODEL, D_IN_PROJ), D_MODEL ** -0.5),
        'decay_base': nrm((L, N_DIR, D_RWKV), 0.5),
        'w_decay_up': nrm((L, N_DIR, DECAY_LORA, D_RWKV), DECAY_LORA ** -0.5),
        'iclr_base': nrm((L, N_DIR, D_RWKV), 0.5),
        'w_iclr_up': nrm((L, N_DIR, ICLR_LORA, D_RWKV), ICLR_LORA ** -0.5),
        'w_gate_up': nrm((L, GATE_LORA, D_RWKV), GATE_LORA ** -0.5),
        'k_k': 0.85 + nrm((L, D_RWKV), 0.05),
        'k_a': 1.0 + nrm((L, D_RWKV), 0.05),
        'r_k': nrm((L, N_RWKV_HEADS, HEAD_DIM), 0.1),
        'lnx_g': 1.0 + nrm((L, D_RWKV), 0.05),
        'lnx_b': nrm((L, D_RWKV), 0.01),
        'ssm_lambda_re': -0.5 + nrm((L, N_SSM_GROUPS, SSM_STATE), 0.02),
        'ssm_lambda_im': lam_im_base + nrm((L, N_SSM_GROUPS, SSM_STATE), 0.02),
        'ssm_log_dt': jax.random.uniform(next(ks), (L, N_DIR, N_SSM_GROUPS), jnp.float32,
                                         math.log(1e-3), math.log(1e-1)),
        'ssm_b_re': nrm((L, N_DIR, N_SSM_GROUPS, SSM_STATE, SSM_GROUP), (2 * SSM_GROUP) ** -0.5),
        'ssm_b_im': nrm((L, N_DIR, N_SSM_GROUPS, SSM_STATE, SSM_GROUP), (2 * SSM_GROUP) ** -0.5),
        'ssm_c_re': nrm((L, N_DIR, N_SSM_GROUPS, SSM_GROUP, SSM_STATE), SSM_STATE ** -0.5),
        'ssm_c_im': nrm((L, N_DIR, N_SSM_GROUPS, SSM_GROUP, SSM_STATE), SSM_STATE ** -0.5),
        'ssm_d': nrm((L, D_SSM), 0.5),
        'w_glu': nrm((L, D_SSM, D_SSM), D_SSM ** -0.5),
        'b_glu': nrm((L, D_SSM), 0.01),
        'w_out': nrm((L, D_MIX, D_MODEL), D_MIX ** -0.5),
        'w_ff1': nrm((L, D_MODEL, D_FF), D_MODEL ** -0.5),
        'w_ff2': nrm((L, D_FF, D_MODEL), D_FF ** -0.5),
        'norm_f_g': 1.0 + nrm((D_MODEL,), 0.05),
    }


def reference(x_prompt, x_sample, c, c_ctx, state_rwkv, state_ssm_re, state_ssm_im,
              norm1_g, norm2_g, w_ada, b_ada, w_in, decay_base, w_decay_up, iclr_base, w_iclr_up,
              w_gate_up, k_k, k_a, r_k, lnx_g, lnx_b, ssm_lambda_re, ssm_lambda_im, ssm_log_dt,
              ssm_b_re, ssm_b_im, ssm_c_re, ssm_c_im, ssm_d, w_glu, b_glu, w_out, w_ff1, w_ff2,
              norm_f_g):
    n_ctx_req = x_prompt.shape[0]
    xp = x_prompt
    cond_ctx = c_ctx[None]
    zero_rwkv = jnp.zeros((n_ctx_req, N_DIR, N_RWKV_HEADS, HEAD_DIM, HEAD_DIM), jnp.float32)
    zero_ssm = jnp.zeros((n_ctx_req, N_DIR, N_SSM_GROUPS, SSM_STATE), jnp.float32)
    n_tok = x_sample.shape[1]
    xs = x_sample + grid_pos_embed(n_tok, D_MODEL).astype(x_sample.dtype)[None]
    new_rwkv, new_re, new_im = [], [], []
    for l in range(DEPTH):
        lp = dict(norm1_g=norm1_g[l], norm2_g=norm2_g[l], w_ada=w_ada[l], b_ada=b_ada[l], w_in=w_in[l],
                  decay_base=decay_base[l], w_decay_up=w_decay_up[l], iclr_base=iclr_base[l],
                  w_iclr_up=w_iclr_up[l], w_gate_up=w_gate_up[l], k_k=k_k[l], k_a=k_a[l], r_k=r_k[l],
                  lnx_g=lnx_g[l], lnx_b=lnx_b[l], ssm_lambda_re=ssm_lambda_re[l],
                  ssm_lambda_im=ssm_lambda_im[l], ssm_log_dt=ssm_log_dt[l], ssm_b_re=ssm_b_re[l],
                  ssm_b_im=ssm_b_im[l], ssm_c_re=ssm_c_re[l], ssm_c_im=ssm_c_im[l], ssm_d=ssm_d[l],
                  w_glu=w_glu[l], b_glu=b_glu[l], w_out=w_out[l], w_ff1=w_ff1[l], w_ff2=w_ff2[l])
        xp, s_r, s_re, s_im = trunk_layer(xp, cond_ctx, zero_rwkv, zero_ssm, zero_ssm, lp)
        new_rwkv.append(s_r)
        new_re.append(s_re)
        new_im.append(s_im)
        xs, _, _, _ = trunk_layer(xs, c, state_rwkv[:, l], state_ssm_re[:, l], state_ssm_im[:, l], lp)
    y_prompt = rms_norm(xp, norm_f_g)
    y_sample = rms_norm(xs, norm_f_g)
    new_state_rwkv = jnp.stack(new_rwkv, axis=1)
    new_state_ssm_re = jnp.stack(new_re, axis=1)
    new_state_ssm_im = jnp.stack(new_im, axis=1)
    return (y_prompt, y_sample, new_state_rwkv, new_state_ssm_re, new_state_ssm_im)
```

```cpp
#include <hip/hip_runtime.h>
#include <cstdio>
#include <cstdint>
#include <math.h>
namespace pg8 {
#define PG8_LAS __attribute__((address_space(3)))
typedef unsigned short bf16_t;
typedef short bf16x8 __attribute__((ext_vector_type(8)));
typedef float f32x4 __attribute__((ext_vector_type(4)));
typedef unsigned u32x4 __attribute__((ext_vector_type(4)));
constexpr int BM = 256, BK = 64, HALF = 128, HTB = HALF * BK * 2  , STAGE_BYTES = 8 * HTB, NXCD = 8, WGM = 8;

__host__ __device__ __forceinline__ int lds_byte(int r, int c) { const int st = (r >> 4) * 2 + (c >> 5), rr = r & 15, cc = c & 31, ob = rr * 64 + cc * 2; return st * 1024 + (ob ^ (((ob >> 9) & 1) << 5)); }
__host__ __device__ __forceinline__ void stage_rc(int b, int& R, int& C) { const int st = b / 1024, sb = b % 1024, swz = sb ^ (((sb >> 9) & 1) << 5); R = (st >> 1) * 16 + swz / 64; C = (st & 1) * 32 + (swz % 64) / 2; }
__host__ __device__ __forceinline__ int perm32(int rho) { const int n = rho >> 4, i = rho & 15; return 8 * (i >> 2) + 4 * n + (i & 3); }

struct Unit { int pm, pn; };
struct Gemm { const bf16_t* A; const bf16_t* Bt; int M, N, K; };

struct StaticOrder {
    int nM, nN, nwg, G, c;
    __host__ __device__ void init(int M, int N, int G_, int c_, int bm = BM) { nM = M / bm; nN = N / BM; nwg = nM * nN; G = G_; c = c_; }
    __host__ __device__ bool next(int i, Unit& u) const {
        const long L = (long)i * G + c; if (L >= nwg) return false;
        int wgid = (int)L; { const int q = nwg / NXCD, r = nwg % NXCD, xcd = wgid % NXCD, off = wgid / NXCD; wgid = (xcd < r ? xcd * (q + 1) : r * (q + 1) + (xcd - r) * q) + off; }
        const int nig = WGM * nN, gid = wgid / nig, fm = gid * WGM, gsz = (nM - fm) < WGM ? (nM - fm) : WGM;
        u.pm = fm + ((wgid % nig) % gsz); u.pn = (wgid % nig) / gsz; return true;
    }
    __device__ __forceinline__ void a_ready(const Unit&) const {}
    __device__ __forceinline__ void done(const Unit&) const {}
};

__device__ __forceinline__ unsigned cvt_pk_bf16(float lo, float hi) { unsigned r; asm volatile("v_cvt_pk_bf16_f32 %0, %1, %2" : "=v"(r) : "v"(lo), "v"(hi)); return r; }
typedef float f32x2 __attribute__((ext_vector_type(2)));
__device__ __forceinline__ float bf2f(unsigned short u) { return __builtin_bit_cast(float, (unsigned)u << 16); }
struct EpiStore {
    static constexpr bool PERM = true, AFTER_DRAIN = false;
    bf16_t* O; int ldc; int act;
    __device__ __forceinline__ void operator()(const f32x4 (&acc)[2][2][4][2], const Unit& u, int wr, int wc, int fr, int fq) const {
        const int row0 = u.pm * BM + wr * 64 + fr, col0 = u.pn * BM + wc * 32 + 8 * fq;
#pragma unroll
        for (int ai = 0; ai < 2; ++ai)
#pragma unroll
            for (int m = 0; m < 4; ++m) { bf16_t* rowp = O + (size_t)(row0 + ai * HALF + m * 16) * ldc + col0;
#pragma unroll
                for (int bj = 0; bj < 2; ++bj) { f32x4 v0 = acc[ai][bj][m][0], v1 = acc[ai][bj][m][1];
                    if (act == 1) {
#pragma unroll
                        for (int e = 0; e < 4; ++e) { float a = v0[e] > 0.f ? v0[e] : 0.f, b = v1[e] > 0.f ? v1[e] : 0.f; v0[e] = a * a; v1[e] = b * b; } }
                    if (act == 2) { const int c = col0 + bj * HALF;
                        if (c >= 1536 && c < 1664) {
#pragma unroll
                            for (int e = 0; e < 4; ++e) { v0[e] = 1.f - 2.f * __builtin_amdgcn_rcpf(1.f + __expf(2.f * v0[e])); v1[e] = 1.f - 2.f * __builtin_amdgcn_rcpf(1.f + __expf(2.f * v1[e])); } }
                        else if (c >= 1792 && c < 1920) {
#pragma unroll
                            for (int e = 0; e < 4; ++e) { v0[e] = __builtin_amdgcn_rcpf(1.f + __expf(-v0[e])); v1[e] = __builtin_amdgcn_rcpf(1.f + __expf(-v1[e])); } } }
                    u32x4 w; w.x = cvt_pk_bf16(v0[0], v0[1]); w.y = cvt_pk_bf16(v0[2], v0[3]); w.z = cvt_pk_bf16(v1[0], v1[1]); w.w = cvt_pk_bf16(v1[2], v1[3]);
                    *(u32x4*)(rowp + bj * HALF) = w; } }
    }
};
struct EpiResid {
    static constexpr bool PERM = true, AFTER_DRAIN = false;
    float* X; const float* mod; int goff;
    __device__ __forceinline__ void operator()(const f32x4 (&acc)[2][2][4][2], const Unit& u, int wr, int wc, int fr, int fq) const {
        const int row0 = u.pm * BM + wr * 64 + fr, col0 = u.pn * BM + wc * 32 + 8 * fq;
        const int ci = u.pm < 16 ? 0 : (u.pm < 32 ? 1 : 2);
        const float* g = mod + ci * 6144 + goff + col0;
        f32x4 gv[2][2];
#pragma unroll
        for (int bj = 0; bj < 2; ++bj)
#pragma unroll
            for (int n = 0; n < 2; ++n) gv[bj][n] = *(const f32x4*)(g + bj * HALF + 4 * n);
#pragma unroll
        for (int ai = 0; ai < 2; ++ai)
#pragma unroll
            for (int m = 0; m < 4; ++m) { float* rowp = X + (size_t)(row0 + ai * HALF + m * 16) * 1024 + col0;
#pragma unroll
                for (int bj = 0; bj < 2; ++bj)
#pragma unroll
                    for (int n = 0; n < 2; ++n) { f32x4* px = (f32x4*)(rowp + bj * HALF + 4 * n); f32x4 x = *px; x = x + gv[bj][n] * acc[ai][bj][m][n]; *px = x; } }
    }
};
struct EpiGlu {
    static constexpr bool PERM = true, AFTER_DRAIN = false;
    bf16_t* MIX; const bf16_t* YS; const float* bglu;
    __device__ __forceinline__ void operator()(const f32x4 (&acc)[2][2][4][2], const Unit& u, int wr, int wc, int fr, int fq) const {
        const int row0 = u.pm * BM + wr * 64 + fr, col0 = u.pn * BM + wc * 32 + 8 * fq;
#pragma unroll
        for (int ai = 0; ai < 2; ++ai)
#pragma unroll
            for (int m = 0; m < 4; ++m) { const int row = row0 + ai * HALF + m * 16;
#pragma unroll
                for (int bj = 0; bj < 2; ++bj) { const int col = col0 + bj * HALF;
                    const u32x4 yv = *(const u32x4*)(YS + (size_t)row * 512 + col);
                    const f32x4 b0 = *(const f32x4*)(bglu + col), b1 = *(const f32x4*)(bglu + col + 4);
                    float y[8]; y[0] = bf2f(yv.x & 0xffff); y[1] = bf2f(yv.x >> 16); y[2] = bf2f(yv.y & 0xffff); y[3] = bf2f(yv.y >> 16);
                    y[4] = bf2f(yv.z & 0xffff); y[5] = bf2f(yv.z >> 16); y[6] = bf2f(yv.w & 0xffff); y[7] = bf2f(yv.w >> 16);
                    float o[8];
#pragma unroll
                    for (int e = 0; e < 4; ++e) { o[e] = y[e] * __builtin_amdgcn_rcpf(1.f + __expf(-(acc[ai][bj][m][0][e] + b0[e]))); o[4 + e] = y[4 + e] * __builtin_amdgcn_rcpf(1.f + __expf(-(acc[ai][bj][m][1][e] + b1[e]))); }
                    u32x4 w; w.x = cvt_pk_bf16(o[0], o[1]); w.y = cvt_pk_bf16(o[2], o[3]); w.z = cvt_pk_bf16(o[4], o[5]); w.w = cvt_pk_bf16(o[6], o[7]);
                    *(u32x4*)(MIX + (size_t)row * 1024 + 512 + col) = w; } }
    }
};

struct RowStat { unsigned* xs; unsigned* cnt; };
template <int MR>
__device__ __forceinline__ void row_rs_exchange(const RowStat& R, const float (&ss)[2][4], const Unit& u, int wr, int wc, int fr, int fq, PG8_LAS unsigned char* lds) {
    PG8_LAS float* P = (PG8_LAS float*)lds; PG8_LAS float* S = P + 1024;
#pragma unroll
    for (int ai = 0; ai < 2; ++ai)
#pragma unroll
        for (int m = 0; m < MR; ++m) { float s = ss[ai][m]; s += __shfl_xor(s, 16); s += __shfl_xor(s, 32);
            if (fq == 0) P[(ai * 32 * MR + wr * 16 * MR + m * 16 + fr) * 4 + wc] = s; }
    __syncthreads();
    int tid = threadIdx.x; asm volatile("" : "+v"(tid));
    if (tid < 64 * MR) { const f32x4 p = *(const PG8_LAS f32x4*)(P + tid * 4); const float t = (p[0] + p[1]) + (p[2] + p[3]);
        __hip_atomic_store(R.xs + ((size_t)u.pm * 4 + u.pn) * 256 + tid, __builtin_bit_cast(unsigned, t), __ATOMIC_RELAXED, __HIP_MEMORY_SCOPE_AGENT); }
    asm volatile("s_waitcnt vmcnt(0)" ::: "memory");
    __syncthreads();
    if (tid == 0) {
        unsigned* c = R.cnt + 64 * u.pm;
        (void)__hip_atomic_fetch_add(c, 1u, __ATOMIC_RELAXED, __HIP_MEMORY_SCOPE_AGENT);
        unsigned sp = 0;
        while (__hip_atomic_load(c, __ATOMIC_RELAXED, __HIP_MEMORY_SCOPE_AGENT) < 4u) { __builtin_amdgcn_s_sleep(1); if (++sp > (1u << 22)) break; }
        __builtin_amdgcn_fence(__ATOMIC_ACQUIRE, "agent");
        asm volatile("s_waitcnt vmcnt(0)" ::: "memory");
    }
    __syncthreads();
    if (tid < 64 * MR) { float t = 0.f;
#pragma unroll
        for (int q = 0; q < 4; ++q) t += __builtin_bit_cast(float, __hip_atomic_load(R.xs + ((size_t)u.pm * 4 + q) * 256 + tid, __ATOMIC_RELAXED, __HIP_MEMORY_SCOPE_AGENT));
        S[tid] = rsqrtf(t * (1.0f / 1024.0f) + 1e-6f); }
    __syncthreads();
}
template <bool FINAL, int MR> struct EpiResidNorm {
    static constexpr bool PERM = true, AFTER_DRAIN = true;
    float* X; const float* mod; const float* ng; bf16_t* XN; RowStat R; const float* xp;
    __device__ __forceinline__ void operator()(const f32x4 (&)[2][2][4][2], const Unit&, int, int, int, int) const {}
    __device__ __forceinline__ void fused(const f32x4 (&acc)[2][2][4][2], const Unit& u, int wr, int wc, int fr, int fq, PG8_LAS unsigned char* lds, int, int) const {
        const int rl0 = wr * 16 * MR + fr, col0 = u.pn * BM + wc * 32 + 8 * fq;
        float ss[2][4];
#pragma unroll
        for (int ai = 0; ai < 2; ++ai)
#pragma unroll
            for (int m = 0; m < MR; ++m) { const int row = u.pm * 64 * MR + ai * 32 * MR + m * 16 + rl0; const int ci = row < 4096 ? 0 : (row < 8192 ? 1 : 2);
                const float* gp = mod + ci * 6144 + (FINAL ? 5 : 2) * 1024 + col0; float* rowp = X + (size_t)row * 1024 + col0; float s = 0.f;
#pragma unroll
                for (int bj = 0; bj < 2; ++bj)
#pragma unroll
                    for (int n = 0; n < 2; ++n) { f32x4* px = (f32x4*)(rowp + bj * HALF + 4 * n); const f32x4* pb = (!FINAL && row < 4096) ? (const f32x4*)(xp + (size_t)row * 1024 + col0 + bj * HALF + 4 * n) : px;
                        const f32x4 x = *pb + *(const f32x4*)(gp + bj * HALF + 4 * n) * acc[ai][bj][m][n]; *px = x; s += (x[0] * x[0] + x[1] * x[1]) + (x[2] * x[2] + x[3] * x[3]); }
                ss[ai][m] = s; }
        row_rs_exchange<MR>(R, ss, u, wr, wc, fr, fq, lds);
        PG8_LAS const float* S = (PG8_LAS const float*)lds + 1024;
#pragma unroll
        for (int ai = 0; ai < 2; ++ai)
#pragma unroll
            for (int m = 0; m < MR; ++m) { const int rl = ai * 32 * MR + m * 16 + rl0, row = u.pm * 64 * MR + rl; const int ci = row < 4096 ? 0 : (row < 8192 ? 1 : 2);
                const float rs = S[rl]; float* rowp = X + (size_t)row * 1024 + col0; const float* md = mod + ci * 6144 + col0;
#pragma unroll
                for (int bj = 0; bj < 2; ++bj) {
                    f32x4 h0 = *(const f32x4*)(rowp + bj * HALF) * rs * *(const f32x4*)(ng + col0 + bj * HALF), h1 = *(const f32x4*)(rowp + bj * HALF + 4) * rs * *(const f32x4*)(ng + col0 + bj * HALF + 4);
                    if (FINAL) { *(f32x4*)(rowp + bj * HALF) = h0; *(f32x4*)(rowp + bj * HALF + 4) = h1; }
                    else { h0 = h0 * (*(const f32x4*)(md + 4 * 1024 + bj * HALF) + 1.f) + *(const f32x4*)(md + 3 * 1024 + bj * HALF); h1 = h1 * (*(const f32x4*)(md + 4 * 1024 + bj * HALF + 4) + 1.f) + *(const f32x4*)(md + 3 * 1024 + bj * HALF + 4);
                        u32x4 w; w.x = cvt_pk_bf16(h0[0], h0[1]); w.y = cvt_pk_bf16(h0[2], h0[3]); w.z = cvt_pk_bf16(h1[0], h1[1]); w.w = cvt_pk_bf16(h1[2], h1[3]);
                        *(u32x4*)(XN + (size_t)row * 1024 + col0 + bj * HALF) = w; } } }
    }
};

template <class Epi, class Sched, bool ALIGN_EPI = false, bool SP2 = false, int MR = 4  >
__device__ __forceinline__ void gemm_phase(PG8_LAS unsigned char* lds, const Gemm g, const Sched& S, const Epi& E) {
    const int tid = threadIdx.x, wid = __builtin_amdgcn_readfirstlane(tid >> 6), lane = tid & 63, wr = wid >> 2, wc = wid & 3, fr = lane & 15, fq = lane >> 4;
    const int K = g.K, nt = K / BK;
    unsigned voffA[2], voffB[2];
#pragma unroll
    for (int i = 0; i < 2; ++i) { int R, C; stage_rc(tid * 16 + i * 8192, R, C); const int Rb = Epi::PERM ? ((R & ~31) + perm32(R & 31)) : R;
        const int Ra = MR == 4 ? R : (16 * MR) * (R >> 6) + ((R & 63) < 16 * MR ? (R & 63) : 16 * MR - 1);
        voffA[i] = (unsigned)(Ra * K + C) * 2u; voffB[i] = (unsigned)(Rb * K + C) * 2u; }
    const size_t kstep = (size_t)(BK * 2);
    const size_t hstep = (size_t)HALF * K * 2;
    const size_t tstep = 2 * hstep;
    const size_t hstepA = (size_t)(32 * MR) * K * 2, tstepA = 2 * hstepA;
    const unsigned ldsw = (unsigned)wid * 1024u;
    const int aoff = lds_byte(wr * 64 + fr, fq * 8), boff = lds_byte(wc * 32 + fr, fq * 8);
#define PG8_SA(b, h) (((b) * 2 + (h)) * HTB)
#define PG8_SB(b, h) ((4 + (b) * 2 + (h)) * HTB)
#define PG8_STAGE(bufoff, gbase, voff) do { _Pragma("unroll") for (int _i = 0; _i < 2; ++_i) \
        __builtin_amdgcn_global_load_lds((const unsigned*)((const char*)(gbase) + (voff)[_i]), (PG8_LAS unsigned*)(lds + (bufoff) + ldsw + _i * 8192), 16, 0, 0); } while (0)
#define PG8_LDA(dst, b, h) do { _Pragma("unroll") for (int m = 0; m < MR; ++m) _Pragma("unroll") for (int k = 0; k < 2; ++k) dst[m][k] = *(const PG8_LAS bf16x8*)(lds + PG8_SA(b, h) + aoff + m * 2048 + k * 1024); } while (0)
#define PG8_LDB(dst, b, h) do { _Pragma("unroll") for (int n = 0; n < 2; ++n) _Pragma("unroll") for (int k = 0; k < 2; ++k) dst[n][k] = *(const PG8_LAS bf16x8*)(lds + PG8_SB(b, h) + boff + n * 2048 + k * 1024); } while (0)
#define PG8_MMA(ai, bj, At, Bt) do { __builtin_amdgcn_s_setprio(1); _Pragma("unroll") for (int m = 0; m < MR; ++m) _Pragma("unroll") for (int n = 0; n < 2; ++n) _Pragma("unroll") for (int k = 0; k < 2; ++k) \
        acc[ai][bj][m][n] = __builtin_amdgcn_mfma_f32_16x16x32_bf16(Bt[n][k], At[m][k], acc[ai][bj][m][n], 0, 0, 0); __builtin_amdgcn_s_setprio(0); } while (0)
#define PG8_WAIT_V(n) asm volatile("s_waitcnt vmcnt(" #n ")" ::: "memory")
#define PG8_WAIT_L(n) asm volatile("s_waitcnt lgkmcnt(" #n ")" ::: "memory")
#define PG8_BAR __builtin_amdgcn_s_barrier()
#define PG8_SCHED __builtin_amdgcn_sched_barrier(0)
    Unit cur, nxt; int ui = 0;
    if (!S.next(0, cur)) return;
    f32x4 acc[2][2][4][2];
#pragma unroll
    for (int a = 0; a < 2; ++a)
#pragma unroll
        for (int b = 0; b < 2; ++b)
#pragma unroll
            for (int m = 0; m < 4; ++m)
#pragma unroll
                for (int n = 0; n < 2; ++n) acc[a][b][m][n] = (f32x4){0.f, 0.f, 0.f, 0.f};
    bf16x8 At[4][2], B0[2][2], B1[2][2];
    const char* cA = (const char*)g.A + (size_t)cur.pm * tstepA; const char* cB = (const char*)g.Bt + (size_t)cur.pn * tstep;
    S.a_ready(cur);
    if constexpr (SP2) {
        PG8_STAGE(PG8_SB(0, 0), cB, voffB); PG8_STAGE(PG8_SB(0, 1), cB + hstep, voffB); PG8_STAGE(PG8_SA(0, 0), cA, voffA); PG8_STAGE(PG8_SA(0, 1), cA + hstepA, voffA);
        if (wr == 1) PG8_BAR;
        PG8_WAIT_V(2); PG8_BAR;
        PG8_STAGE(PG8_SB(1, 0), cB + kstep, voffB); PG8_STAGE(PG8_SA(1, 0), cA + kstep, voffA); PG8_STAGE(PG8_SB(1, 1), cB + hstep + kstep, voffB);
        PG8_WAIT_V(6); PG8_BAR;
    } else {
        PG8_STAGE(PG8_SB(0, 0), cB, voffB); PG8_STAGE(PG8_SA(0, 0), cA, voffA); PG8_STAGE(PG8_SB(0, 1), cB + hstep, voffB); PG8_STAGE(PG8_SA(0, 1), cA + hstepA, voffA);
        if (wr == 1) PG8_BAR;
        PG8_WAIT_V(4); PG8_BAR;
        PG8_STAGE(PG8_SB(1, 0), cB + kstep, voffB); PG8_STAGE(PG8_SA(1, 0), cA + kstep, voffA); PG8_STAGE(PG8_SB(1, 1), cB + hstep + kstep, voffB);
        PG8_WAIT_V(6); PG8_BAR;
    }
    for (;;) {
        const bool has_next = S.next(ui + 1, nxt);
        const char* nA = has_next ? (const char*)g.A + (size_t)nxt.pm * tstepA : cA; const char* nB = has_next ? (const char*)g.Bt + (size_t)nxt.pn * tstep : cB;
        for (int t = 0; t < nt; t += 2) {
            const bool last = (t == nt - 2);
            const char* a1 = cA + (size_t)(t + 1) * kstep;
            const char* a2 = last ? nA : cA + (size_t)(t + 2) * kstep; const char* b2 = last ? nB : cB + (size_t)(t + 2) * kstep;
            const char* a3 = a2 + kstep; const char* b3 = b2 + kstep;
            if (last && has_next) S.a_ready(nxt);
            if constexpr (SP2) {
            PG8_LDB(B0, 0, 0); PG8_LDB(B1, 0, 1); PG8_SCHED; PG8_LDA(At, 0, 0); PG8_STAGE(PG8_SA(1, 1), a1 + hstepA, voffA);
            PG8_WAIT_V(8); PG8_WAIT_L(0); PG8_BAR; PG8_MMA(0, 0, At, B0); PG8_MMA(0, 1, At, B1); PG8_BAR; PG8_SCHED;
            PG8_LDA(At, 0, 1); PG8_STAGE(PG8_SB(0, 0), b2, voffB); PG8_STAGE(PG8_SB(0, 1), b2 + hstep, voffB); PG8_STAGE(PG8_SA(0, 0), a2, voffA);
            PG8_WAIT_V(8); PG8_WAIT_L(0); PG8_BAR; PG8_MMA(1, 0, At, B0); PG8_MMA(1, 1, At, B1); PG8_BAR; PG8_SCHED;
            PG8_LDB(B0, 1, 0); PG8_LDB(B1, 1, 1); PG8_SCHED; PG8_LDA(At, 1, 0); PG8_STAGE(PG8_SA(0, 1), a2 + hstepA, voffA);
            PG8_WAIT_V(8); PG8_WAIT_L(0); PG8_BAR; PG8_MMA(0, 0, At, B0); PG8_MMA(0, 1, At, B1); PG8_BAR; PG8_SCHED;
            PG8_LDA(At, 1, 1); PG8_STAGE(PG8_SB(1, 0), b3, voffB); PG8_STAGE(PG8_SB(1, 1), b3 + hstep, voffB); PG8_STAGE(PG8_SA(1, 0), a3, voffA);
            PG8_WAIT_V(8); PG8_WAIT_L(0); PG8_BAR; PG8_MMA(1, 0, At, B0); PG8_MMA(1, 1, At, B1); PG8_BAR; PG8_SCHED;
            } else {
            PG8_LDB(B0, 0, 0); PG8_SCHED; PG8_LDA(At, 0, 0); PG8_STAGE(PG8_SA(1, 1), a1 + hstepA, voffA);
            PG8_WAIT_L(8); PG8_BAR; PG8_WAIT_L(0); PG8_MMA(0, 0, At, B0); PG8_BAR; PG8_SCHED;
            PG8_LDB(B1, 0, 1); PG8_STAGE(PG8_SB(0, 0), b2, voffB);
            PG8_BAR; PG8_WAIT_L(0); PG8_MMA(0, 1, At, B1); PG8_BAR;
            PG8_LDA(At, 0, 1); PG8_STAGE(PG8_SA(0, 0), a2, voffA);
            PG8_BAR; PG8_WAIT_L(0); PG8_MMA(1, 0, At, B0); PG8_BAR; PG8_SCHED;
            PG8_STAGE(PG8_SB(0, 1), b2 + hstep, voffB);
            PG8_WAIT_V(6); PG8_BAR; PG8_MMA(1, 1, At, B1); PG8_BAR;
            PG8_LDB(B0, 1, 0); PG8_SCHED; PG8_LDA(At, 1, 0); PG8_STAGE(PG8_SA(0, 1), a2 + hstepA, voffA);
            PG8_WAIT_L(8); PG8_BAR; PG8_WAIT_L(0); PG8_MMA(0, 0, At, B0); PG8_BAR; PG8_SCHED;
            PG8_LDB(B1, 1, 1); PG8_STAGE(PG8_SB(1, 0), b3, voffB);
            PG8_BAR; PG8_WAIT_L(0); PG8_MMA(0, 1, At, B1); PG8_BAR;
            PG8_LDA(At, 1, 1); PG8_STAGE(PG8_SA(1, 0), a3, voffA);
            PG8_BAR; PG8_WAIT_L(0); PG8_MMA(1, 0, At, B0); PG8_BAR; PG8_SCHED;
            PG8_STAGE(PG8_SB(1, 1), b3 + hstep, voffB);
            PG8_WAIT_V(6); PG8_BAR; PG8_MMA(1, 1, At, B1); PG8_BAR;
            }
        }
        if constexpr (ALIGN_EPI) { if (wr == 0) PG8_BAR; }
        if constexpr (!Epi::AFTER_DRAIN) { E(acc, cur, wr, wc, fr, fq); S.done(cur); }
        if (!has_next) break;
#pragma unroll
        for (int a = 0; a < 2; ++a)
#pragma unroll
            for (int b = 0; b < 2; ++b)
#pragma unroll
                for (int m = 0; m < 4; ++m)
#pragma unroll
                    for (int n = 0; n < 2; ++n) acc[a][b][m][n] = (f32x4){0.f, 0.f, 0.f, 0.f};
        cur = nxt; cA = nA; cB = nB; ++ui;
        if constexpr (ALIGN_EPI) { if (wr == 1) PG8_BAR; }
    }
    PG8_WAIT_V(0);
    if constexpr (!ALIGN_EPI) { if (wr == 0) PG8_BAR; }
    PG8_BAR;
    if constexpr (Epi::AFTER_DRAIN) { E.fused(acc, cur, wr, wc, fr, fq, lds, wid, lane); S.done(cur); }
#undef PG8_SA
#undef PG8_SB
#undef PG8_STAGE
#undef PG8_LDA
#undef PG8_LDB
#undef PG8_MMA
#undef PG8_WAIT_V
#undef PG8_WAIT_L
#undef PG8_BAR
#undef PG8_SCHED
}
}

constexpr int NWAVES = 8, NTHR = 512;
constexpr int D = 1024, CTX_B = 16, CTX_T = 256, LAT_B = 2, LAT_T = 4096;
constexpr int M_CTX = CTX_B * CTX_T, M_LAT = LAT_B * LAT_T, M = M_CTX + M_LAT;
constexpr int NSEQ = CTX_B + LAT_B;
constexpr int DR = 512, HD = 64, NH = 8, LORA = 64, GLORA = 128, DS = 512, SG = 16, NG = 32, SP = 64, DFF = 4096, NMOD = 6, MODW = NMOD * D;
constexpr int DZW = 2432;
constexpr int DZ = 2560;
constexpr int OFF_R = 0, OFF_K = 512, OFF_V = 1024, OFF_WD = 1536, OFF_AD = 1664, OFF_GD = 1792, OFF_U = 2048;
__host__ __device__ inline int seq_T(int s) { return s < CTX_B ? CTX_T : LAT_T; }
__host__ __device__ inline int seq_row0(int s) { return s < CTX_B ? s * CTX_T : M_CTX + (s - CTX_B) * LAT_T; }
__device__ inline int row_cond(int m) { return m < M_CTX ? 0 : 1 + (m - M_CTX) / LAT_T; }

constexpr size_t MiB = 1u << 20;
constexpr size_t WS_CTL = 0, CTL_ZERO_BYTES = 1 * MiB, WS_END = 256 * MiB;
constexpr size_t WS_MOD = 1 * MiB;
constexpr size_t WS_PE = 1 * MiB + 128 * 1024;
constexpr size_t WS_WIN = 2 * MiB, WS_WOUT = 7 * MiB, WS_WFF1 = 9 * MiB, WS_WFF2 = 17 * MiB, WS_WGLU = 25 * MiB;
constexpr size_t WS_S5C = 1 * MiB + 256 * 1024, WS_S5BB = WS_S5C + 128 * 1024, WS_S5CT = WS_S5BB + 256 * 1024;
static_assert(WS_S5CT + 256 * 1024 <= 2 * MiB, "ws map");
constexpr size_t WS_XN = 26 * MiB;
constexpr size_t WS_MIX = 50 * MiB;
constexpr size_t WS_Z = 74 * MiB;
constexpr size_t WS_YS = 134 * MiB;
constexpr size_t WS_WDU = 25 * MiB + 512 * 1024, WS_WIU = WS_WDU + 128 * 1024, WS_WGU = WS_WIU + 128 * 1024;
static_assert(WS_WGU + 128 * 1024 <= WS_XN, "ws map");
constexpr size_t CHUNKB = (size_t)(M / 64) * NH * 2 * 8192;
constexpr size_t WS_RS = WS_XN;
constexpr size_t WS_RP = 146 * MiB, WS_RQ = WS_RP + CHUNKB, WS_RG = WS_RQ + CHUNKB, WS_RY = WS_RG + CHUNKB;
constexpr size_t WS_HLOC = WS_RY + CHUNKB, WS_HIN = WS_HLOC + 7 * MiB;
constexpr size_t WS_HSEG = 9 * MiB;
static_assert(WS_HSEG + (size_t)(M / 64) * 64 * 4 * 64 * 4 <= WS_WFF2 + 8 * MiB, "ws map");
static_assert(WS_RS + CHUNKB <= WS_MIX && WS_YS + (size_t)M * DS * 2 <= WS_RP && WS_HIN + 7 * MiB <= WS_END, "ws map");
constexpr size_t WS_H = 74 * MiB;
static_assert(WS_H + (size_t)M * DFF * 2 <= WS_END, "ws map");

constexpr int LDS_BYTES = 153600;
constexpr int LDSCTL_OFF = 149504, MISC_OFF = LDSCTL_OFF + 320;
constexpr int CW_BAR = 0;
constexpr size_t CTL_MEMSET_BYTES = 65536;
constexpr int CW_RS = 4096;
constexpr size_t WS_BONUS = 640 * 1024;
constexpr size_t WS_XS = 128 * 1024;
static_assert((CW_RS + 2 * 4096) * 4 <= (int)CTL_MEMSET_BYTES && CTL_MEMSET_BYTES <= WS_XS && WS_XS + 2 * 262144 <= WS_BONUS && WS_BONUS + (size_t)12288 * 8 * 4 <= MiB, "control map");
#define GAS __attribute__((address_space(1)))
#define LAS __attribute__((address_space(3)))
typedef unsigned short bf16;
typedef unsigned v4u __attribute__((ext_vector_type(4)));
typedef float f32x4 __attribute__((ext_vector_type(4)));
#define LDS_WAIT() asm volatile("s_waitcnt lgkmcnt(0)" ::: "memory")
#define VM_WAIT() asm volatile("s_waitcnt vmcnt(0)" ::: "memory")
__device__ __forceinline__ unsigned f2bf(float f) { unsigned u = __builtin_bit_cast(unsigned, f); return (u + 0x7fffu + ((u >> 16) & 1u)) >> 16; }
typedef float f32x2_t __attribute__((ext_vector_type(2)));
typedef __bf16 bf16x2_t __attribute__((ext_vector_type(2)));
__device__ __forceinline__ unsigned pk2(float lo, float hi) { const f32x2_t v = {lo, hi}; const bf16x2_t b = __builtin_convertvector(v, bf16x2_t); return __builtin_bit_cast(unsigned, b); }
__device__ __forceinline__ float bf2f(bf16 u) { return __builtin_bit_cast(float, (unsigned)u << 16); }
__device__ __forceinline__ float sigmoidf_(float x) { return 1.f / (1.f + expf(-x)); }
__device__ __forceinline__ float frcp(float x) { return __builtin_amdgcn_rcpf(x); }
__device__ __forceinline__ float wave_sum(float v) {
#pragma unroll
    for (int o = 1; o < 64; o <<= 1) v += __shfl_xor(v, o);
    return v;
}

struct Args {
    const float* in[36];
    float* out; unsigned char* ws;
    int ph_lo, ph_hi;
};
enum { I_XP = 0, I_XS, I_C, I_CCTX, I_SRWKV, I_SRE, I_SIM, I_N1G, I_N2G, I_WADA, I_BADA, I_WIN, I_DBASE, I_WDUP, I_IBASE, I_WIUP, I_WGUP, I_KK, I_KA, I_RK, I_LNXG, I_LNXB,
       I_LRE, I_LIM, I_LDT, I_BRE, I_BIM, I_CRE, I_CIM, I_SSMD, I_WGLU, I_BGLU, I_WOUT, I_WFF1, I_WFF2, I_NFG };

struct Frame {
    LAS unsigned char* lds;
    int tid, lane, wave, G, bid;
};

typedef short bf16x8 __attribute__((ext_vector_type(8)));
typedef float f32x16 __attribute__((ext_vector_type(16)));
typedef float f32x2 __attribute__((ext_vector_type(2)));
constexpr int NGLU_WG = (M / 256) * (DS / 256);
constexpr int NUNIT = M / 64;
__device__ __forceinline__ void p0_s5_tables(const Frame& F, const Args& a) {
    float* S5C = (float*)(a.ws + WS_S5C); bf16* BB = (bf16*)(a.ws + WS_S5BB); bf16* CT = (bf16*)(a.ws + WS_S5CT);
    for (int i = F.bid + F.G * F.tid; i < 2 * NG * SP; i += F.G * NTHR) {
        const int p = i & 63, g = (i >> 6) & 31, dir = i >> 11;
        const double lre = a.in[I_LRE][g * SP + p], lim = a.in[I_LIM][g * SP + p], dt = exp((double)a.in[I_LDT][dir * NG + g]);
        const double ar = lre * dt, ai = lim * dt;
        const double er = exp(ar), lbr = er * cos(ai), lbi = er * sin(ai);
        double pr = lbr, pi = lbi, p16r = 0.0, p16i = 0.0;
#pragma unroll
        for (int q = 0; q < 6; ++q) { const double nr = pr * pr - pi * pi, ni = 2.0 * pr * pi; pr = nr; pi = ni; if (q == 3) { p16r = pr; p16i = pi; } }
        float* cs = S5C + ((size_t)(dir * NG + g) * 6) * 64 + p;
        cs[0 * 64] = (float)lbr; cs[1 * 64] = (float)lbi; cs[2 * 64] = (float)p16r; cs[3 * 64] = (float)p16i;
        cs[4 * 64] = (float)pr; cs[5 * 64] = (float)pi;
        const double nr = lbr - 1.0, ni = lbi, den = lre * lre + lim * lim; const double qr = (nr * lre + ni * lim) / den, qi = (ni * lre - nr * lim) / den;
        for (int h = 0; h < 16; ++h) {
            const double br = a.in[I_BRE][(((size_t)dir * NG + g) * SP + p) * SG + h], bi = a.in[I_BIM][(((size_t)dir * NG + g) * SP + p) * SG + h];
            BB[((((size_t)dir * NG + g) * 2 + 0) * 64 + p) * 16 + h] = (bf16)f2bf((float)(qr * br - qi * bi));
            BB[((((size_t)dir * NG + g) * 2 + 1) * 64 + p) * 16 + h] = (bf16)f2bf((float)(qr * bi + qi * br));
            CT[(((size_t)dir * NG + g) * 16 + h) * 128 + 2 * p + 0] = (bf16)f2bf(a.in[I_CRE][(((size_t)dir * NG + g) * SG + h) * SP + p]);
            CT[(((size_t)dir * NG + g) * 16 + h) * 128 + 2 * p + 1] = (bf16)f2bf(-a.in[I_CIM][(((size_t)dir * NG + g) * SG + h) * SP + p]);
        }
    }
}
template <bool PC>
__device__ __forceinline__ void s5_unit(const Frame& F, const Args& a, int unit, int g) {
    const int lane = F.lane, cc = lane & 31, hh = lane >> 5;
    const bf16* Z = (const bf16*)(a.ws + WS_Z); const float* S5C = (const float*)(a.ws + WS_S5C); const bf16* BB = (const bf16*)(a.ws + WS_S5BB); const bf16* CT = (const bf16*)(a.ws + WS_S5CT);
    f32x2* HLOC = (f32x2*)(a.ws + WS_HLOC); const f32x2* HIN = (const f32x2*)(a.ws + WS_HIN); bf16* YS = (bf16*)(a.ws + WS_YS);
    unsigned* HSEG = (unsigned*)(a.ws + WS_HSEG);
    const int rowbase = unit * 64;
    LAS unsigned char* hl = F.lds + F.wave * 8704;
    const int tau = 16 * ((cc >> 2) & 1) + (cc & 3) + 4 * (cc >> 3);
    {
        f32x4 yacc[2][2];
#pragma unroll
        for (int i = 0; i < 2; ++i)
#pragma unroll
            for (int j = 0; j < 2; ++j) yacc[i][j] = (f32x4){0.f, 0.f, 0.f, 0.f};
        for (int dir = 0; dir < 2; ++dir) {
            const int dg = dir * NG + g;
            const float* cs = S5C + (size_t)dg * 6 * 64;
            float lbr[2], lbi[2], l16r[2], l16i[2], cr[2], ci[2];
            bf16x8 bfr[2][2];
#pragma unroll
            for (int pt = 0; pt < 2; ++pt) {
                const int p = 32 * pt + cc;
                lbr[pt] = cs[p]; lbi[pt] = cs[64 + p]; l16r[pt] = cs[128 + p]; l16i[pt] = cs[192 + p];
                bfr[pt][0] = *(const bf16x8*)(BB + (((size_t)dg * 2 + 0) * 64 + p) * 16 + 8 * hh);
                bfr[pt][1] = *(const bf16x8*)(BB + (((size_t)dg * 2 + 1) * 64 + p) * 16 + 8 * hh);
                if (PC) { const f32x2 h0 = HIN[((size_t)unit * 64 + dg) * 64 + p]; cr[pt] = h0.x; ci[pt] = h0.y; } else { cr[pt] = 0.f; ci[pt] = 0.f; }
            }
            bf16x8 cfr[4];
            if (PC) {
#pragma unroll
                for (int ks = 0; ks < 4; ++ks) cfr[ks] = *(const bf16x8*)(CT + ((size_t)dg * 16 + (lane & 15)) * 128 + 32 * ks + 8 * (lane >> 4));
            }
#pragma unroll
            for (int k = 0; k < 2; ++k) {
                const int pos = 32 * k + tau, t = dir ? 63 - pos : pos;
                const bf16x8 afr = *(const bf16x8*)(Z + (size_t)(rowbase + t) * DZ + OFF_U + g * 16 + 8 * hh);
#pragma unroll
                for (int pt = 0; pt < 2; ++pt) {
                    f32x16 xr = {0.f, 0.f, 0.f, 0.f, 0.f, 0.f, 0.f, 0.f, 0.f, 0.f, 0.f, 0.f, 0.f, 0.f, 0.f, 0.f}, xi = xr;
                    xr = __builtin_amdgcn_mfma_f32_32x32x16_bf16(afr, bfr[pt][0], xr, 0, 0, 0);
                    xi = __builtin_amdgcn_mfma_f32_32x32x16_bf16(afr, bfr[pt][1], xi, 0, 0, 0);
                    float e0r, e0i, e1r, e1i;
                    const size_t sgi = (((size_t)unit * 64 + dg) * 4 + 2 * k) * 64 + 32 * pt + cc;
                    if (PC) { const unsigned w0 = HSEG[sgi], w1 = HSEG[sgi + 64];
                        e0r = bf2f((bf16)(w0 & 0xffff)); e0i = bf2f((bf16)(w0 >> 16)); e1r = bf2f((bf16)(w1 & 0xffff)); e1i = bf2f((bf16)(w1 >> 16)); }
                    else {
                        float lr = 0.f, li = 0.f;
#pragma unroll
                        for (int q = 0; q < 16; ++q) { const float nr = lbr[pt] * lr - lbi[pt] * li + xr[q], ni = lbr[pt] * li + lbi[pt] * lr + xi[q]; lr = nr; li = ni; }
                        HSEG[sgi + 64 * hh] = pk2(lr, li);
                        const float pr = __shfl_xor(lr, 32), pi = __shfl_xor(li, 32);
                        e0r = hh ? pr : lr; e0i = hh ? pi : li; e1r = hh ? lr : pr; e1i = hh ? li : pi; }
                    const float mr = l16r[pt] * cr[pt] - l16i[pt] * ci[pt] + e0r, mi = l16r[pt] * ci[pt] + l16i[pt] * cr[pt] + e0i;
                    float qr = hh ? mr : cr[pt], qi = hh ? mi : ci[pt];
                    cr[pt] = l16r[pt] * mr - l16i[pt] * mi + e1r; ci[pt] = l16r[pt] * mi + l16i[pt] * mr + e1i;
                    if (PC) {
#pragma unroll
                        for (int q = 0; q < 16; ++q) { const float nr = lbr[pt] * qr - lbi[pt] * qi + xr[q], ni = lbr[pt] * qi + lbi[pt] * qr + xi[q]; qr = nr; qi = ni;
                            *(LAS unsigned*)(hl + (16 * hh + q) * 272 + (32 * pt + cc) * 4) = pk2(qr, qi); }
                    }
                }
                if (PC) {
                    asm volatile("s_waitcnt lgkmcnt(0)" ::: "memory");
                    const int kn = dir ? 1 - k : k;
#pragma unroll
                    for (int mt = 0; mt < 2; ++mt) {
                        const int lrow = dir ? 31 - 16 * mt - (lane & 15) : 16 * mt + (lane & 15);
#pragma unroll
                        for (int ks = 0; ks < 4; ++ks) {
                            const bf16x8 hfr = *(const LAS bf16x8*)(hl + lrow * 272 + (32 * ks + 8 * (lane >> 4)) * 2);
                            if (kn == 0) yacc[0][mt] = __builtin_amdgcn_mfma_f32_16x16x32_bf16(hfr, cfr[ks], yacc[0][mt], 0, 0, 0);
                            else yacc[1][mt] = __builtin_amdgcn_mfma_f32_16x16x32_bf16(hfr, cfr[ks], yacc[1][mt], 0, 0, 0);
                        }
                    }
                    asm volatile("s_waitcnt lgkmcnt(0)" ::: "memory");
                }
            }
            if (!PC) { if (hh == 0) {
#pragma unroll
                for (int pt = 0; pt < 2; ++pt) HLOC[((size_t)unit * 64 + dg) * 64 + 32 * pt + cc] = (f32x2){cr[pt], ci[pt]}; } }
        }
        if (PC) {
            const int ho = lane & 15, qd = lane >> 4, ch = g * 16 + ho; const float dsk = a.in[I_SSMD][ch];
#pragma unroll
            for (int kn = 0; kn < 2; ++kn)
#pragma unroll
                for (int mt = 0; mt < 2; ++mt)
#pragma unroll
                    for (int i = 0; i < 4; ++i) {
                        const int row = rowbase + 32 * kn + 16 * mt + 4 * qd + i;
                        const float u = bf2f(Z[(size_t)row * DZ + OFF_U + ch]); const float y = yacc[kn][mt][i] + dsk * u;
                        const float zz = 1.5957691216057308f * (y + 0.044715f * y * y * y);
                        YS[(size_t)row * DS + ch] = (bf16)f2bf(y * frcp(1.f + __expf(-zz)));
                    }
        }
    }
}
__device__ __forceinline__ void s5_pass_ctx(const Frame& F, const Args& a, int ch) {
    const f32x2* HLOC = (const f32x2*)(a.ws + WS_HLOC); f32x2* HIN = (f32x2*)(a.ws + WS_HIN); const float* S5C = (const float*)(a.ws + WS_S5C);
    float* out_sre = a.out + (size_t)M * D + (size_t)CTX_B * 2 * NH * HD * HD; float* out_sim = out_sre + (size_t)CTX_B * 2 * NG * SP;
    const int s = ch >> 12, dgp = ch & 4095, dg = dgp >> 6, p = dgp & 63, dir = dg >> 5, unit0 = seq_row0(s) / 64;
    const float l64r = S5C[(size_t)dg * 384 + 256 + p], l64i = S5C[(size_t)dg * 384 + 320 + p];
    float hr = 0.f, hi = 0.f;
    f32x2 e[4];
#pragma unroll
    for (int j = 0; j < 4; ++j) { const int c = dir ? 3 - j : j; e[j] = HLOC[((size_t)(unit0 + c) * 64 + dg) * 64 + p]; }
#pragma unroll
    for (int j = 0; j < 4; ++j) { const int c = dir ? 3 - j : j; HIN[((size_t)(unit0 + c) * 64 + dg) * 64 + p] = (f32x2){hr, hi};
        const float nr = l64r * hr - l64i * hi + e[j].x, ni = l64r * hi + l64i * hr + e[j].y; hr = nr; hi = ni; }
    out_sre[(size_t)s * 4096 + dgp] = hr; out_sim[(size_t)s * 4096 + dgp] = hi;
}
__device__ __forceinline__ void s5_pass_lat(const Frame& F, const Args& a, int lc) {
    const f32x2* HLOC = (const f32x2*)(a.ws + WS_HLOC); f32x2* HIN = (f32x2*)(a.ws + WS_HIN); const float* S5C = (const float*)(a.ws + WS_S5C);
    const int b = lc >> 12, dgp = lc & 4095, dg = dgp >> 6, p = dgp & 63, dir = dg >> 5, unit0 = seq_row0(CTX_B + b) / 64;
    constexpr int nc = LAT_T / 64;
    const float l64r = S5C[(size_t)dg * 384 + 256 + p], l64i = S5C[(size_t)dg * 384 + 320 + p];
    float hr = a.in[I_SRE][(size_t)b * 4096 + dgp], hi = a.in[I_SIM][(size_t)b * 4096 + dgp];
    const f32x2* hl = HLOC + ((size_t)unit0 * 64 + dg) * 64 + p; f32x2* hn = HIN + ((size_t)unit0 * 64 + dg) * 64 + p;
    f32x2 e[nc];
#pragma unroll
    for (int j = 0; j < nc; ++j) { const int c = dir ? nc - 1 - j : j; e[j] = hl[(size_t)c * 4096]; }
#pragma unroll
    for (int j = 0; j < nc; ++j) { const int c = dir ? nc - 1 - j : j; hn[(size_t)c * 4096] = (f32x2){hr, hi};
        const float nr = l64r * hr - l64i * hi + e[j].x, ni = l64r * hi + l64i * hr + e[j].y; hr = nr; hi = ni; }
}

typedef short s16x4 __attribute__((ext_vector_type(4)));
typedef short v4i16_t __attribute__((ext_vector_type(4)));
typedef unsigned v2u __attribute__((ext_vector_type(2)));
namespace rw {
constexpr int RS = 144, MAT = 64 * RS;
constexpr int S_RM = 0, S_KM = 1, S_VM = 2, S_WD = 3, S_AD = 4, S_AT = 5, S_BT = 6, S_KT = 7, S_RT = 8, S_PB = 9, S_TA = 10, S_TB = 11, S_W1 = 12, S_UL = 13;
constexpr int S_AAK = 0, S_ARB = 1, S_ARK = 3, S_PA = 4, S_UZ = 0;
constexpr int LW_OFF = 9 * MAT, AA_OFF = LW_OFF + 64 * 272, SM_OFF = 14 * MAT;
static_assert(AA_OFF + 64 * 272 <= 13 * MAT && SM_OFF + 512 <= LDS_BYTES, "rwkv LDS map");
__device__ __forceinline__ s16x4 ldtr(const LAS unsigned char* p) { return __builtin_bit_cast(s16x4, __builtin_amdgcn_ds_read_tr16_b64_v4i16((LAS v4i16_t*)p)); }
__device__ __forceinline__ bf16x8 frag_d(const LAS unsigned char* Mx, int row, int ks, int fq) { return *(const LAS bf16x8*)(Mx + row * RS + (32 * ks + 8 * fq) * 2); }
__device__ __forceinline__ bf16x8 frag_t(const LAS unsigned char* Mx, int tile, int ks, int lane) {
    const int fq = lane >> 4, li = lane & 15;
    const LAS unsigned char* p = Mx + (32 * ks + 8 * fq + (li >> 2)) * RS + (16 * tile + 4 * (li & 3)) * 2;
    const s16x4 lo = ldtr(p), hi = ldtr(p + 4 * RS);
    return (bf16x8){lo.x, lo.y, lo.z, lo.w, hi.x, hi.y, hi.z, hi.w};
}
#define MFMA16(a, b, c) __builtin_amdgcn_mfma_f32_16x16x32_bf16(a, b, c, 0, 0, 0)
#define MFMA16K(a, b, c) __builtin_amdgcn_mfma_f32_16x16x16bf16_1k(a, b, c, 0, 0, 0)
template <bool XTR, bool YTR>
__device__ __forceinline__ void mm2(const LAS unsigned char* X, const LAS unsigned char* Y, int mt, int nt0, f32x4 (&acc)[2], int lane) {
#pragma unroll
    for (int ks = 0; ks < 2; ++ks) {
        const bf16x8 xb = XTR ? frag_t(X, mt, ks, lane) : frag_d(X, 16 * mt + (lane & 15), ks, lane >> 4);
#pragma unroll
        for (int e = 0; e < 2; ++e) { const bf16x8 ya = YTR ? frag_t(Y, nt0 + e, ks, lane) : frag_d(Y, 16 * (nt0 + e) + (lane & 15), ks, lane >> 4); acc[e] = MFMA16(ya, xb, acc[e]); }
    }
}
__device__ __forceinline__ void st4(LAS unsigned char* Mx, int m, int n, const f32x4 v) { *(LAS v2u*)(Mx + m * RS + n * 2) = (v2u){pk2(v[0], v[1]), pk2(v[2], v[3])}; }
__device__ __forceinline__ f32x4 ld4(const LAS unsigned char* Mx, int m, int n) { const v2u w = *(const LAS v2u*)(Mx + m * RS + n * 2);
    return (f32x4){bf2f((bf16)(w.x & 0xffff)), bf2f((bf16)(w.x >> 16)), bf2f((bf16)(w.y & 0xffff)), bf2f((bf16)(w.y >> 16))}; }
__device__ __forceinline__ void stg4(bf16* g, const f32x4 v) { *(GAS v2u*)g = (v2u){pk2(v[0], v[1]), pk2(v[2], v[3])}; }
}
__device__ __forceinline__ f32x4 ldg4bf(const bf16* g) { const v2u w = *(const GAS v2u*)g;
    return (f32x4){bf2f((bf16)(w.x & 0xffff)), bf2f((bf16)(w.x >> 16)), bf2f((bf16)(w.y & 0xffff)), bf2f((bf16)(w.y >> 16))}; }

__device__ __forceinline__ void p0_lora(const Frame& F, const Args& a) {
    bf16* WDU = (bf16*)(a.ws + WS_WDU); bf16* WIU = (bf16*)(a.ws + WS_WIU); bf16* WGU = (bf16*)(a.ws + WS_WGU);
    for (int i = F.bid * NTHR + F.tid; i < 2 * DR * LORA; i += F.G * NTHR) { const int r = i & 63, c = (i >> 6) & 511, dir = i >> 15;
        WDU[i] = (bf16)f2bf(-1.4426950408889634f * a.in[I_WDUP][((size_t)dir * LORA + r) * DR + c]); WIU[i] = (bf16)f2bf(-1.4426950408889634f * a.in[I_WIUP][((size_t)dir * LORA + r) * DR + c]); }
    for (int i = F.bid * NTHR + F.tid; i < DR * GLORA; i += F.G * NTHR) { const int r = i & 127, c = i >> 7; WGU[i] = (bf16)f2bf(a.in[I_WGUP][(size_t)r * DR + c]); }
}

struct RaConst { bf16x8 wb0, wb1; float base, kk8[8], kkc[2], kac[2]; };
struct RaPre { v4u x[3]; v4u f[8]; };
__device__ __forceinline__ void ra_consts(const Frame& F, const Args& a, int h, int dir, RaConst& C) {
    const int tid = F.tid, lane = F.lane, w = F.wave, fr = lane & 15, fq = lane >> 4;
    const int jt = w & 3, isA = w >> 2, c = 64 * h + 16 * jt + fr;
    const bf16* Wt = (const bf16*)(a.ws + (isA ? WS_WIU : WS_WDU)) + ((size_t)dir * DR + c) * LORA;
    C.wb0 = *(const bf16x8*)(Wt + 8 * fq); C.wb1 = *(const bf16x8*)(Wt + 32 + 8 * fq);
    C.base = a.in[isA ? I_IBASE : I_DBASE][dir * DR + c];
#pragma unroll
    for (int e = 0; e < 8; ++e) C.kk8[e] = a.in[I_KK][64 * h + 8 * (tid & 7) + e];
#pragma unroll
    for (int e = 0; e < 1; ++e) { const int j = tid >> 3; C.kkc[0] = a.in[I_KK][64 * h + j]; C.kac[0] = a.in[I_KA][64 * h + j]; C.kkc[1] = 0.f; C.kac[1] = 0.f; }
}
__device__ __forceinline__ void ra_prefetch(const Frame& F, const Args& a, int unit, int h, int dir, RaPre& Pf) {
    const int tid = F.tid, lane = F.lane, w = F.wave, fr = lane & 15, fq = lane >> 4;
    const bf16* Z = (const bf16*)(a.ws + WS_Z); const int rowbase = unit * 64;
    { const int tau = tid >> 3, c8 = tid & 7, tok = dir ? 63 - tau : tau; const bf16* zr = Z + (size_t)(rowbase + tok) * DZ + 64 * h + 8 * c8;
      Pf.x[0] = *(const GAS v4u*)(zr + OFF_R); Pf.x[1] = *(const GAS v4u*)(zr + OFF_K); Pf.x[2] = *(const GAS v4u*)(zr + OFF_V); }
    { const int isA = w >> 2; const int off = (isA ? OFF_AD : OFF_WD) + 64 * dir + 8 * fq;
#pragma unroll
      for (int tt = 0; tt < 4; ++tt) { const int tau = 16 * tt + fr, tok = dir ? 63 - tau : tau; const bf16* zr = Z + (size_t)(rowbase + tok) * DZ + off;
          Pf.f[2 * tt] = *(const GAS v4u*)zr; Pf.f[2 * tt + 1] = *(const GAS v4u*)(zr + 32); } }
}
__device__ __forceinline__ void ra_unit(const Frame& F, const Args& a, int unit, int h, int dir, const RaConst& C, RaPre& Pf, int next_unit) {
    using namespace rw;
    const int tid = F.tid, lane = F.lane, w = F.wave, fr = lane & 15, fq = lane >> 4;
    LAS unsigned char* L = F.lds;
    const int cu = (unit * NH + h) * 2 + dir;
    LAS float* rn = (LAS float*)(L + SM_OFF); LAS float* gC = rn + 64;
    __syncthreads();
    {
        const int tau = tid >> 3, c8 = tid & 7;
        { const unsigned* xp = (const unsigned*)&Pf.x[1]; float ss = 0.f;
#pragma unroll
          for (int e = 0; e < 4; ++e) { const float lo = bf2f((bf16)(xp[e] & 0xffff)) * C.kk8[2 * e], hi = bf2f((bf16)(xp[e] >> 16)) * C.kk8[2 * e + 1]; ss += lo * lo + hi * hi; }
          ss += __shfl_xor(ss, 1); ss += __shfl_xor(ss, 2); ss += __shfl_xor(ss, 4);
          if (c8 == 0) rn[tau] = frcp(fmaxf(sqrtf(ss), 1e-12f)); }
#pragma unroll
        for (int q = 0; q < 3; ++q) *(LAS v4u*)(L + q * MAT + tau * RS + 16 * (q < 2 ? ((c8 + (tau >> 3)) & 7) : c8)) = Pf.x[q];
    }
    {
        const int jt = w & 3, isA = w >> 2;
        LAS float* dst = (LAS float*)(L + (isA ? AA_OFF : LW_OFF)) + (16 * jt + fr) * 68;
#pragma unroll
        for (int tt = 0; tt < 4; ++tt) {
            v4u f0 = Pf.f[2 * tt], f1 = Pf.f[2 * tt + 1];
            if (!isA) { unsigned* p0 = (unsigned*)&f0; unsigned* p1 = (unsigned*)&f1;
#pragma unroll
                for (int e = 0; e < 4; ++e) { const float a0 = bf2f((bf16)(p0[e] & 0xffff)), a1 = bf2f((bf16)(p0[e] >> 16)), b0 = bf2f((bf16)(p1[e] & 0xffff)), b1 = bf2f((bf16)(p1[e] >> 16));
                    p0[e] = pk2(1.f - 2.f * frcp(1.f + __expf(2.f * a0)), 1.f - 2.f * frcp(1.f + __expf(2.f * a1))); p1[e] = pk2(1.f - 2.f * frcp(1.f + __expf(2.f * b0)), 1.f - 2.f * frcp(1.f + __expf(2.f * b1))); } }
            f32x4 acc = {0.f, 0.f, 0.f, 0.f};
            acc = MFMA16(__builtin_bit_cast(bf16x8, f0), C.wb0, acc); acc = MFMA16(__builtin_bit_cast(bf16x8, f1), C.wb1, acc);
            f32x4 o;
#pragma unroll
            for (int r = 0; r < 4; ++r) { const float sg = frcp(1.f + __expf(-(acc[r] + C.base))); o[r] = isA ? sg : -0.60653065971263342f * sg; }
            *(LAS f32x4*)(dst + 16 * tt + 4 * fq) = o;
        }
    }
    if (next_unit >= 0) ra_prefetch(F, a, next_unit, h, dir, Pf);
    __syncthreads();
    {
        const int j = tid >> 3, seg = tid & 7;
        const LAS float* lwp = (const LAS float*)(L + LW_OFF) + j * 68 + 8 * seg; const LAS float* aap = (const LAS float*)(L + AA_OFF) + j * 68 + 8 * seg;
        float lw[8], av[8], Lc[8];
        { const f32x4 x0 = *(const LAS f32x4*)lwp, x1 = *(const LAS f32x4*)(lwp + 4), y0 = *(const LAS f32x4*)aap, y1 = *(const LAS f32x4*)(aap + 4);
#pragma unroll
          for (int e = 0; e < 4; ++e) { lw[e] = x0[e]; lw[4 + e] = x1[e]; av[e] = y0[e]; av[4 + e] = y1[e]; } }
        float run = 0.f;
#pragma unroll
        for (int e = 0; e < 8; ++e) { run += lw[e]; Lc[e] = run; }
        float v = run;
#pragma unroll
        for (int d = 1; d < 8; d <<= 1) { const float t = __shfl_up(v, d, 8); if (seg >= d) v += t; }
        const float excl = v - run;
        const float kkc = C.kkc[0], kac = C.kac[0];
        float oa[8], ob[8], ok[8], orr[8];
#pragma unroll
        for (int e = 0; e < 8; ++e) {
            const int tau = 8 * seg + e; const float lc = Lc[e] + excl;
            const int so = tau * RS + 16 * (((j >> 3) + seg) & 7) + 2 * (j & 7);
            const float rr = bf2f(*(const LAS bf16*)(L + S_RM * MAT + so)), kk0 = bf2f(*(const LAS bf16*)(L + S_KM * MAT + so));
            const float kkn = kk0 * kkc * rn[tau];
            const float eL = __expf(lc), eLm = __expf(lc - lw[e]), inv = __expf(-lc);
            oa[e] = -kkn * eLm; ob[e] = kkn * av[e] * inv; ok[e] = kk0 * (1.f + (av[e] - 1.f) * kac) * inv; orr[e] = rr * eL;
            if (e == 7 && seg == 7) gC[j] = eL;
        }
        *(LAS v4u*)(L + S_AT * MAT + j * RS + 16 * seg) = (v4u){pk2(oa[0], oa[1]), pk2(oa[2], oa[3]), pk2(oa[4], oa[5]), pk2(oa[6], oa[7])};
        *(LAS v4u*)(L + S_BT * MAT + j * RS + 16 * seg) = (v4u){pk2(ob[0], ob[1]), pk2(ob[2], ob[3]), pk2(ob[4], ob[5]), pk2(ob[6], ob[7])};
        *(LAS v4u*)(L + S_KT * MAT + j * RS + 16 * seg) = (v4u){pk2(ok[0], ok[1]), pk2(ok[2], ok[3]), pk2(ok[4], ok[5]), pk2(ok[6], ok[7])};
        *(LAS v4u*)(L + S_RT * MAT + j * RS + 16 * seg) = (v4u){pk2(orr[0], orr[1]), pk2(orr[2], orr[3]), pk2(orr[4], orr[5]), pk2(orr[6], orr[7])};
    }
    __syncthreads();
    const int mt = w >> 1, nt0 = 2 * (w & 1), m = 16 * mt + fr;
    const f32x4 z4 = {0.f, 0.f, 0.f, 0.f};
    {
        f32x4 ab[2] = {z4, z4}, ak[2] = {z4, z4}, rb[2] = {z4, z4}, rk[2] = {z4, z4};
        mm2<true, true>(L + S_AT * MAT, L + S_BT * MAT, mt, nt0, ab, lane); mm2<true, true>(L + S_AT * MAT, L + S_KT * MAT, mt, nt0, ak, lane);
        mm2<true, true>(L + S_RT * MAT, L + S_BT * MAT, mt, nt0, rb, lane); mm2<true, true>(L + S_RT * MAT, L + S_KT * MAT, mt, nt0, rk, lane);
#pragma unroll
        for (int e = 0; e < 2; ++e) { const int n = 16 * (nt0 + e) + 4 * fq; f32x4 t1;
#pragma unroll
            for (int r = 0; r < 4; ++r) { const bool lo = (n + r) < m, le = (n + r) <= m; ab[e][r] = lo ? ab[e][r] : 0.f; ak[e][r] = lo ? ak[e][r] : 0.f; rb[e][r] = le ? rb[e][r] : 0.f; rk[e][r] = le ? rk[e][r] : 0.f;
                t1[r] = ab[e][r] + ((n + r) == m ? 1.f : 0.f); }
            st4(L + S_PA * MAT, m, n, ab[e]); st4(L + S_TA * MAT, m, n, t1); st4(L + S_AAK * MAT, m, n, ak[e]); st4(L + S_ARB * MAT, m, n, rb[e]); st4(L + S_ARK * MAT, m, n, rk[e]); }
    }
    __syncthreads();
    {
        f32x4 p1[2] = {z4, z4}, w1[2] = {z4, z4};
        mm2<false, true>(L + S_PA * MAT, L + S_PA * MAT, mt, nt0, p1, lane); mm2<false, true>(L + S_AAK * MAT, L + S_VM * MAT, mt, nt0, w1, lane);
#pragma unroll
        for (int e = 0; e < 2; ++e) { const int n = 16 * (nt0 + e) + 4 * fq; st4(L + S_PB * MAT, m, n, p1[e]); st4(L + S_W1 * MAT, m, n, w1[e]); }
    }
    __syncthreads();
#pragma unroll 1
    for (int it = 0; it < 4; ++it) {
        const LAS unsigned char* To = L + ((it & 1) ? S_TB : S_TA) * MAT; LAS unsigned char* Tn = L + ((it & 1) ? S_TA : S_TB) * MAT;
        const LAS unsigned char* Pc = L + ((it & 1) ? S_PA : S_PB) * MAT; LAS unsigned char* Pn = L + ((it & 1) ? S_PB : S_PA) * MAT;
        f32x4 tn[2], pn[2] = {z4, z4};
#pragma unroll
        for (int e = 0; e < 2; ++e) tn[e] = ld4(To, m, 16 * (nt0 + e) + 4 * fq);
        mm2<false, true>(To, Pc, mt, nt0, tn, lane); mm2<false, true>(Pc, Pc, mt, nt0, pn, lane);
#pragma unroll
        for (int e = 0; e < 2; ++e) { const int n = 16 * (nt0 + e) + 4 * fq; st4(Tn, m, n, tn[e]); st4(Pn, m, n, pn[e]); }
        __syncthreads();
    }
    {
        f32x4 tn[2];
#pragma unroll
        for (int e = 0; e < 2; ++e) tn[e] = ld4(L + S_TA * MAT, m, 16 * (nt0 + e) + 4 * fq);
        mm2<false, true>(L + S_TA * MAT, L + S_PB * MAT, mt, nt0, tn, lane);
#pragma unroll
        for (int e = 0; e < 2; ++e) st4(L + S_TB * MAT, m, 16 * (nt0 + e) + 4 * fq, tn[e]);
    }
    __syncthreads();
    {
        f32x4 uz[2] = {z4, z4}, ul[2] = {z4, z4};
        mm2<false, false>(L + S_TB * MAT, L + S_AT * MAT, mt, nt0, uz, lane); mm2<false, true>(L + S_TB * MAT, L + S_W1 * MAT, mt, nt0, ul, lane);
#pragma unroll
        for (int e = 0; e < 2; ++e) { const int n = 16 * (nt0 + e) + 4 * fq; st4(L + S_UZ * MAT, m, n, uz[e]); st4(L + S_UL * MAT, m, n, ul[e]); }
    }
    __syncthreads();
    {
        bf16* Pg = (bf16*)(a.ws + WS_RP) + (size_t)cu * 4096; bf16* Qg = (bf16*)(a.ws + WS_RQ) + (size_t)cu * 4096;
        bf16* Gg = (bf16*)(a.ws + WS_RG) + (size_t)cu * 4096; bf16* Yg = (bf16*)(a.ws + WS_RY) + (size_t)cu * 4096;
        f32x4 pp[2] = {z4, z4}, qq[2] = {z4, z4}, gg[2] = {z4, z4}, yy[2] = {z4, z4};
        mm2<false, true>(L + S_BT * MAT, L + S_UZ * MAT, mt, nt0, pp, lane);
        mm2<true, false>(L + S_UL * MAT, L + S_BT * MAT, mt, nt0, qq, lane); mm2<true, false>(L + S_VM * MAT, L + S_KT * MAT, mt, nt0, qq, lane);
        mm2<false, true>(L + S_ARB * MAT, L + S_UZ * MAT, mt, nt0, gg, lane);
        mm2<false, true>(L + S_ARB * MAT, L + S_UL * MAT, mt, nt0, yy, lane); mm2<false, true>(L + S_ARK * MAT, L + S_VM * MAT, mt, nt0, yy, lane);
        const float gm = gC[m];
#pragma unroll
        for (int e = 0; e < 2; ++e) { const int nt = nt0 + e, n = 16 * nt + 4 * fq;
            f32x4 po, qo, go;
#pragma unroll
            for (int r = 0; r < 4; ++r) { po[r] = gm * (pp[e][r] + ((n + r) == m ? 1.f : 0.f)); qo[r] = gC[n + r] * qq[e][r];
                go[r] = gg[e][r] + bf2f(*(const LAS bf16*)(L + S_RT * MAT + (n + r) * RS + 2 * m)); }
            stg4(Pg + m * 64 + 32 * (nt >> 1) + 8 * fq + 4 * (nt & 1), po);
            stg4(Qg + m * 64 + 16 * fq + 4 * nt, qo); stg4(Gg + m * 64 + 16 * fq + 4 * nt, go); stg4(Yg + m * 64 + n, yy[e]); }
    }
}

namespace rw {
constexpr int UNIT_LDS = 8 * MAT + 512;
constexpr int V_RM = 0, V_KM = 1, V_VM = 2, V_AT = 3, V_BT = 4, V_KT = 5, V_RT = 6, V_W1 = 7, V_PA = 0, V_PB = 1, V_UZ = 0, V_UL = 1, V_SM = 8 * MAT;
static_assert(2 * UNIT_LDS <= LDSCTL_OFF, "rwkv v2 LDS map");
__device__ __forceinline__ bf16x8 frag_tp(const LAS unsigned char* Mx, int tile, int ks, int lane) {
    const int fq = lane >> 4, li = lane & 15;
    const LAS unsigned char* p = Mx + (32 * ks + 4 * fq + (li >> 2)) * RS + (16 * tile + 4 * (li & 3)) * 2;
    const s16x4 lo = ldtr(p), hi = ldtr(p + 16 * RS);
    return (bf16x8){lo.x, lo.y, lo.z, lo.w, hi.x, hi.y, hi.z, hi.w};
}
__device__ __forceinline__ bf16x8 frag_dp(const LAS unsigned char* Mx, int row, int ks, int fq) {
    const v2u a = *(const LAS v2u*)(Mx + row * RS + (32 * ks + 4 * fq) * 2), b = *(const LAS v2u*)(Mx + row * RS + (32 * ks + 16 + 4 * fq) * 2);
    return __builtin_bit_cast(bf16x8, (v4u){a.x, a.y, b.x, b.y});
}
__device__ __forceinline__ s16x4 pk4(const f32x4 v) { return __builtin_bit_cast(s16x4, (v2u){pk2(v[0], v[1]), pk2(v[2], v[3])}); }
__device__ __forceinline__ bf16x8 xpack(const f32x4 lo, const f32x4 hi) { return __builtin_bit_cast(bf16x8, (v4u){pk2(lo[0], lo[1]), pk2(lo[2], lo[3]), pk2(hi[0], hi[1]), pk2(hi[2], hi[3])}); }
}
struct Ra2Const { bf16x8 wd0, wd1, wi0, wi1; float dbase, ibase, kkc, kac; };
struct Ra2Pre { v4u x[3][2]; };
struct Ra2Frag { v4u fd[8]; v4u fi[8]; };
__device__ __forceinline__ void ra2_consts(const Frame& F, const Args& a, int h, int dir, Ra2Const& C, int tid_o, int wv) {
    const int lane = tid_o & 63, fr = lane & 15, fq = lane >> 4, c = 64 * h + 16 * wv + fr;
    const bf16* Wd = (const bf16*)(a.ws + WS_WDU) + ((size_t)dir * DR + c) * LORA; const bf16* Wi = (const bf16*)(a.ws + WS_WIU) + ((size_t)dir * DR + c) * LORA;
    C.wd0 = *(const bf16x8*)(Wd + 8 * fq); C.wd1 = *(const bf16x8*)(Wd + 32 + 8 * fq); C.wi0 = *(const bf16x8*)(Wi + 8 * fq); C.wi1 = *(const bf16x8*)(Wi + 32 + 8 * fq);
    C.dbase = -1.4426950408889634f * a.in[I_DBASE][dir * DR + c]; C.ibase = -1.4426950408889634f * a.in[I_IBASE][dir * DR + c]; C.kkc = a.in[I_KK][c]; C.kac = a.in[I_KA][c];
}
__device__ __forceinline__ void ra2_prefetch(const Frame& F, const Args& a, int unit, int h, int dir, Ra2Pre& Pf, int tid_o) {
    const int tl = tid_o & 255;
    const bf16* Z = (const bf16*)(a.ws + WS_Z); const int rowbase = unit * 64;
    const int tau = tl >> 2, c4 = tl & 3, tok = dir ? 63 - tau : tau; const bf16* zr = Z + (size_t)(rowbase + tok) * DZ + 64 * h + 8 * c4;
#pragma unroll
    for (int q = 0; q < 3; ++q) { Pf.x[q][0] = *(const GAS v4u*)(zr + 512 * q); Pf.x[q][1] = *(const GAS v4u*)(zr + 512 * q + 32); }
}
__device__ __forceinline__ void ra2_frags(const Frame& F, const Args& a, int unit, int dir, Ra2Frag& Fg, int tid_o) {
    const int lane = tid_o & 63, fr = lane & 15, fq = lane >> 4;
    const bf16* Z = (const bf16*)(a.ws + WS_Z); const int rowbase = unit * 64;
#pragma unroll
    for (int tt = 0; tt < 4; ++tt) { const int tau = 16 * tt + fr, tok = dir ? 63 - tau : tau; const bf16* zr = Z + (size_t)(rowbase + tok) * DZ + 64 * dir + 8 * fq;
        Fg.fd[2 * tt] = *(const GAS v4u*)(zr + OFF_WD); Fg.fd[2 * tt + 1] = *(const GAS v4u*)(zr + OFF_WD + 32); Fg.fi[2 * tt] = *(const GAS v4u*)(zr + OFF_AD); Fg.fi[2 * tt + 1] = *(const GAS v4u*)(zr + OFF_AD + 32); }
}
__device__ __forceinline__ v4u tanh8(v4u x) { unsigned* p = (unsigned*)&x;
#pragma unroll
    for (int e = 0; e < 4; ++e) { const float a0 = bf2f((bf16)(p[e] & 0xffff)), a1 = bf2f((bf16)(p[e] >> 16)); p[e] = pk2(1.f - 2.f * frcp(1.f + __expf(2.f * a0)), 1.f - 2.f * frcp(1.f + __expf(2.f * a1))); }
    return x; }
__device__ __forceinline__ void ra2_unit(const Frame& F, const Args& a, int unit, int h, int dir) {
    using namespace rw;
    int tid_o = F.tid; asm volatile("" : "+v"(tid_o));
    const int lane = tid_o & 63, fr = lane & 15, fq = lane >> 4, tl = tid_o & 255;
    const int wv = (F.wave >> 2) ? 3 - (F.wave & 3) : (F.wave & 3);
    const int kmax = wv >> 1;
    LAS unsigned char* L = F.lds + (F.wave >> 2) * UNIT_LDS;
    LAS float* rn = (LAS float*)(L + V_SM); LAS float* gC = rn + 64;
    const int cu = (unit * NH + h) * 2 + dir, m = 16 * wv + fr;
    const f32x4 z4 = {0.f, 0.f, 0.f, 0.f};
    Ra2Const C; ra2_consts(F, a, h, dir, C, tid_o, wv);
    Ra2Pre Pf; ra2_prefetch(F, a, unit, h, dir, Pf, tid_o);
    Ra2Frag Fg; ra2_frags(F, a, unit, dir, Fg, tid_o);
    __syncthreads();
    {
        const int tau = tl >> 2, c4 = tl & 3; float ss = 0.f;
#pragma unroll
        for (int hf = 0; hf < 2; ++hf) { const unsigned* xp = (const unsigned*)&Pf.x[1][hf]; const float* kkp = a.in[I_KK] + 64 * h + 8 * c4 + 32 * hf;
#pragma unroll
            for (int e = 0; e < 4; ++e) { const float lo = bf2f((bf16)(xp[e] & 0xffff)) * kkp[2 * e], hi = bf2f((bf16)(xp[e] >> 16)) * kkp[2 * e + 1]; ss += lo * lo + hi * hi; } }
        ss += __shfl_xor(ss, 1); ss += __shfl_xor(ss, 2);
        if (c4 == 0) rn[tau] = frcp(fmaxf(sqrtf(ss), 1e-12f));
        if (dir == 0) {
            float bs = 0.f;
#pragma unroll
            for (int hf = 0; hf < 2; ++hf) { const unsigned* rp = (const unsigned*)&Pf.x[0][hf]; const unsigned* kp = (const unsigned*)&Pf.x[1][hf]; const float* rkp = a.in[I_RK] + 64 * h + 8 * c4 + 32 * hf;
#pragma unroll
                for (int e = 0; e < 4; ++e) bs += bf2f((bf16)(rp[e] & 0xffff)) * bf2f((bf16)(kp[e] & 0xffff)) * rkp[2 * e] + bf2f((bf16)(rp[e] >> 16)) * bf2f((bf16)(kp[e] >> 16)) * rkp[2 * e + 1]; }
            bs += __shfl_xor(bs, 1); bs += __shfl_xor(bs, 2);
            if (c4 == 0) ((float*)(a.ws + WS_BONUS))[(size_t)(unit * 64 + tau) * NH + h] = bs; }
#pragma unroll
        for (int q = 0; q < 3; ++q)
#pragma unroll
            for (int hf = 0; hf < 2; ++hf) *(LAS v4u*)(L + q * MAT + tau * RS + 16 * (c4 + 4 * hf)) = Pf.x[q][hf];
    }
    f32x4 lw4[4], av4[4];
#pragma unroll
    for (int tt = 0; tt < 4; ++tt) {
        const f32x4 db4 = {C.dbase, C.dbase, C.dbase, C.dbase}, ib4 = {C.ibase, C.ibase, C.ibase, C.ibase};
        f32x4 ad = MFMA16(__builtin_bit_cast(bf16x8, Fg.fd[2 * tt]), C.wd0, db4); ad = MFMA16(__builtin_bit_cast(bf16x8, Fg.fd[2 * tt + 1]), C.wd1, ad);
        f32x4 ai = MFMA16(__builtin_bit_cast(bf16x8, Fg.fi[2 * tt]), C.wi0, ib4); ai = MFMA16(__builtin_bit_cast(bf16x8, Fg.fi[2 * tt + 1]), C.wi1, ai);
#pragma unroll
        for (int r = 0; r < 4; ++r) { lw4[tt][r] = -0.87503878f   * frcp(1.f + __builtin_amdgcn_exp2f(ad[r])); av4[tt][r] = frcp(1.f + __builtin_amdgcn_exp2f(ai[r])); }
    }
    __syncthreads();
    {
        float base = 0.f;
#pragma unroll
        for (int tt = 0; tt < 4; ++tt) {
            const float p0 = lw4[tt][0], p1 = p0 + lw4[tt][1], p2 = p1 + lw4[tt][2], p3 = p2 + lw4[tt][3];
            const float s16 = __shfl_up(p3, 16), s32 = __shfl_up(p3, 32), s48 = __shfl_up(p3, 48);
            const float excl = (fq >= 1 ? s16 : 0.f) + (fq >= 2 ? s32 : 0.f) + (fq >= 3 ? s48 : 0.f);
            float tot = p3; tot += __shfl_xor(tot, 16); tot += __shfl_xor(tot, 32);
            const float pre[4] = {p0, p1, p2, p3};
            f32x4 oa, ob, ok, orr; float eL[4];
#pragma unroll
            for (int r = 0; r < 4; ++r) eL[r] = __builtin_amdgcn_exp2f(base + excl + pre[r]);
            const float ePrev = __builtin_amdgcn_exp2f(base + excl);
#pragma unroll
            for (int r = 0; r < 4; ++r) {
                const int tau = 16 * tt + 4 * fq + r;
                const float rr = bf2f(*(const LAS bf16*)(L + V_RM * MAT + tau * RS + 2 * m)), kk0 = bf2f(*(const LAS bf16*)(L + V_KM * MAT + tau * RS + 2 * m));
                const float kkn = kk0 * C.kkc * rn[tau], avv = av4[tt][r];
                const float eLm = r == 0 ? ePrev : eL[r > 0 ? r - 1 : 0], inv = frcp(eL[r]);
                oa[r] = -kkn * eLm; ob[r] = kkn * avv * inv; ok[r] = kk0 * (1.f + (avv - 1.f) * C.kac) * inv; orr[r] = rr * eL[r];
                if (tt == 3 && r == 3 && fq == 3) gC[m] = eL[r];
            }
            st4(L + V_AT * MAT, m, 16 * tt + 4 * fq, oa); st4(L + V_BT * MAT, m, 16 * tt + 4 * fq, ob); st4(L + V_KT * MAT, m, 16 * tt + 4 * fq, ok); st4(L + V_RT * MAT, m, 16 * tt + 4 * fq, orr);
            base += tot;
        }
    }
    __syncthreads();
    bf16x8 xAak[2], xArb[2], xArk[2]; f32x4 ab[4] = {z4, z4, z4, z4};
    {
        f32x4 ak[4] = {z4, z4, z4, z4}, rb[4] = {z4, z4, z4, z4}, rk[4] = {z4, z4, z4, z4};
#pragma unroll
        for (int ks = 0; ks < 2; ++ks) { const bf16x8 xa = frag_t(L + V_AT * MAT, wv, ks, lane), xr = frag_t(L + V_RT * MAT, wv, ks, lane);
#pragma unroll
            for (int nt = 0; nt < 4; ++nt) { if (nt > wv) continue;
                const bf16x8 yb = frag_t(L + V_BT * MAT, nt, ks, lane), yk = frag_t(L + V_KT * MAT, nt, ks, lane);
                ab[nt] = MFMA16(yb, xa, ab[nt]); ak[nt] = MFMA16(yk, xa, ak[nt]); rb[nt] = MFMA16(yb, xr, rb[nt]); rk[nt] = MFMA16(yk, xr, rk[nt]); } }
#pragma unroll
        for (int nt = 0; nt < 4; ++nt) { const int n = 16 * nt + 4 * fq;
            if (nt == wv) {
#pragma unroll
                for (int r = 0; r < 4; ++r) { const bool lo = (n + r) < m, le = (n + r) <= m; ab[nt][r] = lo ? ab[nt][r] : 0.f; ak[nt][r] = lo ? ak[nt][r] : 0.f; rb[nt][r] = le ? rb[nt][r] : 0.f; rk[nt][r] = le ? rk[nt][r] : 0.f; } }
            if (nt <= wv) st4(L + V_PA * MAT, m, n, ab[nt]); }
#pragma unroll
        for (int ks = 0; ks < 2; ++ks) { xAak[ks] = xpack(ak[2 * ks], ak[2 * ks + 1]); xArb[ks] = xpack(rb[2 * ks], rb[2 * ks + 1]); xArk[ks] = xpack(rk[2 * ks], rk[2 * ks + 1]); }
    }
    bf16x8 xT[2];
    {
        LAS unsigned char* ND = L + V_PB * MAT;
        const int dg = 16 * wv, troff = (4 * fq + (fr >> 2)) * RS + 8 * (fr & 3), wroff = fr * RS + 8 * fq;
        const LAS unsigned char* blkA = L + V_PA * MAT + dg * RS;
        LAS unsigned char* blkD = ND + dg * RS + dg * 2;
        f32x4 t, p;
        { const f32x4 ad = ld4(L + V_PA * MAT, m, dg + 4 * fq);
            const s16x4 ya = ldtr(blkA + dg * 2 + troff); p = MFMA16K(ya, pk4(ad), z4);
#pragma unroll
            for (int r = 0; r < 4; ++r) t[r] = ad[r] + ((4 * fq + r) == fr ? 1.f : 0.f); }
#pragma unroll
        for (int it = 0; it < 3; ++it) {
            const s16x4 xp = pk4(p);
            *(LAS s16x4*)(blkD + wroff) = xp; asm volatile("" ::: "memory");
            const s16x4 yp = ldtr(blkD + troff); asm volatile("" ::: "memory");
            t = MFMA16K(yp, pk4(t), t);
            if (it < 2) p = MFMA16K(yp, xp, z4);
        }
        const s16x4 xd = pk4(t);
        *(LAS s16x4*)(blkD + wroff) = xd;
        f32x4 n0 = z4, n1 = z4, n2 = z4;
        if (wv >= 1) { n0 = MFMA16K(ldtr(blkA + troff), xd, z4); *(LAS s16x4*)(ND + dg * RS + wroff) = pk4(n0); }
        if (wv >= 2) { n1 = MFMA16K(ldtr(blkA + 32 + troff), xd, z4); *(LAS s16x4*)(ND + dg * RS + 32 + wroff) = pk4(n1); }
        if (wv == 3) { n2 = MFMA16K(ldtr(blkA + 64 + troff), xd, z4); *(LAS s16x4*)(ND + dg * RS + 64 + wroff) = pk4(n2); }
        {
            f32x4 w1[4] = {z4, z4, z4, z4};
#pragma unroll
            for (int ks = 0; ks < 2; ++ks)
#pragma unroll
                for (int nt = 0; nt < 4; ++nt) { if (ks > kmax) continue; w1[nt] = MFMA16(frag_tp(L + V_VM * MAT, nt, ks, lane), xAak[ks], w1[nt]); }
#pragma unroll
            for (int nt = 0; nt < 4; ++nt) st4(L + V_W1 * MAT, m, 16 * nt + 4 * fq, w1[nt]);
        }
        __syncthreads();
        f32x4 tp0 = n0, tp1 = n1;
        if (wv >= 2) { const s16x4 y10 = ldtr(ND + 16 * RS + troff);
            tp0 = MFMA16K(y10, pk4(n1), tp0);
            if (wv == 3) { tp0 = MFMA16K(ldtr(ND + 32 * RS + troff), pk4(n2), tp0);
                const f32x4 n21 = MFMA16K(ldtr(ND + 32 * RS + 32 + troff), pk4(n2), z4);
                tp0 = MFMA16K(y10, pk4(n21), tp0);
#pragma unroll
                for (int r = 0; r < 4; ++r) tp1[r] += n21[r]; } }
        v2u w0 = {0u, 0u}, w1_ = {0u, 0u}, w2 = {0u, 0u}, w3 = {0u, 0u}; const v2u wD = __builtin_bit_cast(v2u, xd);
        if (wv >= 1) w0 = __builtin_bit_cast(v2u, pk4(MFMA16K(ldtr(ND + troff), pk4(tp0), z4)));
        if (wv >= 2) w1_ = __builtin_bit_cast(v2u, pk4(MFMA16K(ldtr(ND + 16 * RS + 32 + troff), pk4(tp1), z4)));
        if (wv == 3) w2 = __builtin_bit_cast(v2u, pk4(MFMA16K(ldtr(ND + 32 * RS + 64 + troff), pk4(n2), z4)));
        if (wv == 0) w0 = wD;
        if (wv == 1) w1_ = wD;
        if (wv == 2) w2 = wD;
        if (wv == 3) w3 = wD;
        xT[0] = __builtin_bit_cast(bf16x8, (v4u){w0.x, w0.y, w1_.x, w1_.y}); xT[1] = __builtin_bit_cast(bf16x8, (v4u){w2.x, w2.y, w3.x, w3.y});
        f32x4 uz[4] = {z4, z4, z4, z4};
#pragma unroll
        for (int ks = 0; ks < 2; ++ks)
#pragma unroll
            for (int nt = 0; nt < 4; ++nt) { if (ks > kmax) continue; uz[nt] = MFMA16(frag_dp(L + V_AT * MAT, 16 * nt + fr, ks, fq), xT[ks], uz[nt]); }
#pragma unroll
        for (int nt = 0; nt < 4; ++nt) st4(L + V_UZ * MAT, m, 16 * nt + 4 * fq, uz[nt]);
    }
    __syncthreads();
    {
        f32x4 ul[4] = {z4, z4, z4, z4};
#pragma unroll
        for (int ks = 0; ks < 2; ++ks)
#pragma unroll
            for (int nt = 0; nt < 4; ++nt) { if (ks > kmax) continue; ul[nt] = MFMA16(frag_tp(L + V_W1 * MAT, nt, ks, lane), xT[ks], ul[nt]); }
#pragma unroll
        for (int nt = 0; nt < 4; ++nt) st4(L + V_UL * MAT, m, 16 * nt + 4 * fq, ul[nt]);
    }
    __syncthreads();
    {
        bf16* Pg = (bf16*)(a.ws + WS_RP) + (size_t)cu * 4096; bf16* Qg = (bf16*)(a.ws + WS_RQ) + (size_t)cu * 4096;
        bf16* Gg = (bf16*)(a.ws + WS_RG) + (size_t)cu * 4096; bf16* Yg = (bf16*)(a.ws + WS_RY) + (size_t)cu * 4096;
        f32x4 pp[4] = {z4, z4, z4, z4}, qq[4] = {z4, z4, z4, z4}, gg[4] = {z4, z4, z4, z4}, yy[4] = {z4, z4, z4, z4};
#pragma unroll
        for (int ks = 0; ks < 2; ++ks) {
            const bf16x8 xB = frag_d(L + V_BT * MAT, m, ks, fq), xUl = frag_t(L + V_UL * MAT, wv, ks, lane), xV = frag_t(L + V_VM * MAT, wv, ks, lane);
#pragma unroll
            for (int nt = 0; nt < 4; ++nt) {
                if (ks <= kmax) { gg[nt] = MFMA16(frag_tp(L + V_UZ * MAT, nt, ks, lane), xArb[ks], gg[nt]);
                    yy[nt] = MFMA16(frag_tp(L + V_UL * MAT, nt, ks, lane), xArb[ks], yy[nt]); yy[nt] = MFMA16(frag_tp(L + V_VM * MAT, nt, ks, lane), xArk[ks], yy[nt]); }
                pp[nt] = MFMA16(frag_t(L + V_UZ * MAT, nt, ks, lane), xB, pp[nt]);
                qq[nt] = MFMA16(frag_d(L + V_BT * MAT, 16 * nt + fr, ks, fq), xUl, qq[nt]); qq[nt] = MFMA16(frag_d(L + V_KT * MAT, 16 * nt + fr, ks, fq), xV, qq[nt]); }
        }
        const float gm = gC[m];
#pragma unroll
        for (int nt = 0; nt < 4; ++nt) { const int n = 16 * nt + 4 * fq;
            f32x4 po, qo, go;
#pragma unroll
            for (int r = 0; r < 4; ++r) { po[r] = gm * (pp[nt][r] + ((n + r) == m ? 1.f : 0.f)); qo[r] = gC[n + r] * qq[nt][r];
                go[r] = gg[nt][r] + bf2f(*(const LAS bf16*)(L + V_RT * MAT + (n + r) * RS + 2 * m)); }
            stg4(Pg + m * 64 + 32 * (nt >> 1) + 8 * fq + 4 * (nt & 1), po);
            stg4(Qg + m * 64 + 16 * fq + 4 * nt, qo); stg4(Gg + m * 64 + 16 * fq + 4 * nt, go); stg4(Yg + m * 64 + n, yy[nt]); }
    }
}

__device__ __forceinline__ void rb_chain(const Frame& F, const Args& a, int s, int h, int dir, int wq) {
    const int lane = F.lane, fr = lane & 15, fq = lane >> 4, i = 16 * wq + fr;
    const int nc = seq_T(s) / 64, unit0 = seq_row0(s) / 64;
    const bf16* Pg = (const bf16*)(a.ws + WS_RP); const bf16* Qg = (const bf16*)(a.ws + WS_RQ); bf16* Sg = (bf16*)(a.ws + WS_RS);
    f32x4 acc[4];
    if (s >= CTX_B) { const float* s0 = a.in[I_SRWKV] + ((((size_t)(s - CTX_B) * 2 + dir) * NH + h) * HD + i) * HD;
#pragma unroll
        for (int jt = 0; jt < 4; ++jt) acc[jt] = *(const GAS f32x4*)(s0 + 16 * jt + 4 * fq); }
    else {
#pragma unroll
        for (int jt = 0; jt < 4; ++jt) acc[jt] = (f32x4){0.f, 0.f, 0.f, 0.f}; }
    bf16x8 pf[4][4][2]; v2u qv[4][4];
#define RB_LOAD(slot, st) do { const int c_ = dir ? nc - 1 - (st) : (st); const size_t cu_ = ((size_t)(unit0 + c_) * NH + h) * 2 + dir; \
        _Pragma("unroll") for (int jt = 0; jt < 4; ++jt) { pf[slot][jt][0] = *(const bf16x8*)(Pg + cu_ * 4096 + (16 * jt + fr) * 64 + 8 * fq); pf[slot][jt][1] = *(const bf16x8*)(Pg + cu_ * 4096 + (16 * jt + fr) * 64 + 32 + 8 * fq); \
            } { const v4u q0_ = *(const GAS v4u*)(Qg + cu_ * 4096 + i * 64 + 16 * fq), q1_ = *(const GAS v4u*)(Qg + cu_ * 4096 + i * 64 + 16 * fq + 8); \
            qv[slot][0] = (v2u){q0_.x, q0_.y}; qv[slot][1] = (v2u){q0_.z, q0_.w}; qv[slot][2] = (v2u){q1_.x, q1_.y}; qv[slot][3] = (v2u){q1_.z, q1_.w}; } } while (0)
#define RB_STEP(slot, st) do { const int c_ = dir ? nc - 1 - (st) : (st); const size_t cu_ = ((size_t)(unit0 + c_) * NH + h) * 2 + dir; \
        *(GAS v4u*)(Sg + cu_ * 4096 + i * 64 + 16 * fq) = (v4u){pk2(acc[0][0], acc[0][1]), pk2(acc[0][2], acc[0][3]), pk2(acc[1][0], acc[1][1]), pk2(acc[1][2], acc[1][3])}; \
        *(GAS v4u*)(Sg + cu_ * 4096 + i * 64 + 16 * fq + 8) = (v4u){pk2(acc[2][0], acc[2][1]), pk2(acc[2][2], acc[2][3]), pk2(acc[3][0], acc[3][1]), pk2(acc[3][2], acc[3][3])}; \
        bf16x8 zb[2]; _Pragma("unroll") for (int ks = 0; ks < 2; ++ks) { union { bf16x8 v; unsigned u[4]; } cv; cv.u[0] = pk2(acc[2 * ks][0], acc[2 * ks][1]); cv.u[1] = pk2(acc[2 * ks][2], acc[2 * ks][3]); \
            cv.u[2] = pk2(acc[2 * ks + 1][0], acc[2 * ks + 1][1]); cv.u[3] = pk2(acc[2 * ks + 1][2], acc[2 * ks + 1][3]); zb[ks] = cv.v; } \
        _Pragma("unroll") for (int jt = 0; jt < 4; ++jt) { f32x4 nv = {bf2f((bf16)(qv[slot][jt].x & 0xffff)), bf2f((bf16)(qv[slot][jt].x >> 16)), bf2f((bf16)(qv[slot][jt].y & 0xffff)), bf2f((bf16)(qv[slot][jt].y >> 16))}; \
            nv = MFMA16(pf[slot][jt][0], zb[0], nv); nv = MFMA16(pf[slot][jt][1], zb[1], nv); acc[jt] = nv; } } while (0)
    RB_LOAD(0, 0); RB_LOAD(1, 1); RB_LOAD(2, 2); RB_LOAD(3, 3);
    for (int st = 0; st < nc; st += 4) {
        const int n4 = st + 4 < nc ? st + 4 : nc - 1, n5 = st + 5 < nc ? st + 5 : nc - 1, n6 = st + 6 < nc ? st + 6 : nc - 1, n7 = st + 7 < nc ? st + 7 : nc - 1;
        RB_STEP(0, st);     RB_LOAD(0, n4);
        RB_STEP(1, st + 1); RB_LOAD(1, n5);
        RB_STEP(2, st + 2); RB_LOAD(2, n6);
        RB_STEP(3, st + 3); RB_LOAD(3, n7);
    }
#undef RB_LOAD
#undef RB_STEP
    if (s < CTX_B) { float* so = a.out + (size_t)M * D + ((((size_t)s * 2 + dir) * NH + h) * HD + i) * HD;
#pragma unroll
        for (int jt = 0; jt < 4; ++jt) *(GAS f32x4*)(so + 16 * jt + 4 * fq) = acc[jt]; }
}

__device__ __forceinline__ void rb_latent_coop(const Frame& F, const Args& a, int s, int h, int dir, int wq) {
    const int lane = F.lane, fr = lane & 15, fq = lane >> 4, i = 16 * wq + fr, w = F.wave;
    constexpr int nc = LAT_T / 64, DL = 16;
    const int unit0 = seq_row0(s) / 64;
    const bf16* Pg = (const bf16*)(a.ws + WS_RP); const bf16* Qg = (const bf16*)(a.ws + WS_RQ); bf16* Sg = (bf16*)(a.ws + WS_RS);
    const long dstep = dir ? -65536 : 65536;
    const long off0 = ((long)((unit0 * NH + h) * 2 + dir) + 16 * (dir ? nc - 1 : 0)) * 4096;
    LAS unsigned char* B0 = F.lds; constexpr int BUFB = 10240, S0OFF = 3 * BUFB;
#define RBC_BAR() do { asm volatile("s_waitcnt lgkmcnt(0)" ::: "memory"); __builtin_amdgcn_s_barrier(); asm volatile("" ::: "memory"); } while (0)
    if (w == 0) {
        f32x4 acc[4];
        { const float* s0 = a.in[I_SRWKV] + ((((size_t)(s - CTX_B) * 2 + dir) * NH + h) * HD + i) * HD;
#pragma unroll
            for (int jt = 0; jt < 4; ++jt) acc[jt] = *(const GAS f32x4*)(s0 + 16 * jt + 4 * fq); }
        __syncthreads();
        bf16x8 pa[4][2], pb[4][2]; v4u qa[2], qb[2];
#define RBC_READ(P, Q, stp) do { const LAS unsigned char* Bi_ = B0 + ((stp) % 3) * BUFB; \
            _Pragma("unroll") for (int jt = 0; jt < 4; ++jt) { P[jt][0] = *(const LAS bf16x8*)(Bi_ + (jt * 2) * 1024 + lane * 16); P[jt][1] = *(const LAS bf16x8*)(Bi_ + (jt * 2 + 1) * 1024 + lane * 16); } \
            Q[0] = *(const LAS v4u*)(Bi_ + 8192 + lane * 16); Q[1] = *(const LAS v4u*)(Bi_ + 8192 + 1024 + lane * 16); } while (0)
#define RBC_STEP(P, Q, PN, QN, stp) do { \
            const v4u z0 = (v4u){pk2(acc[0][0], acc[0][1]), pk2(acc[0][2], acc[0][3]), pk2(acc[1][0], acc[1][1]), pk2(acc[1][2], acc[1][3])}, z1 = (v4u){pk2(acc[2][0], acc[2][1]), pk2(acc[2][2], acc[2][3]), pk2(acc[3][0], acc[3][1]), pk2(acc[3][2], acc[3][3])}; \
            *(LAS v4u*)(B0 + S0OFF + ((stp) & 1) * 2048 + lane * 16) = z0; *(LAS v4u*)(B0 + S0OFF + ((stp) & 1) * 2048 + 1024 + lane * 16) = z1;     \
            asm volatile("" ::: "memory"); \
            RBC_READ(PN, QN, (stp) + 1);                                                                                                                  \
            asm volatile("s_waitcnt lgkmcnt(10)\n\ts_barrier" ::: "memory");     \
            const unsigned qw[8] = {Q[0].x, Q[0].y, Q[0].z, Q[0].w, Q[1].x, Q[1].y, Q[1].z, Q[1].w}; \
            const bf16x8 zb0 = __builtin_bit_cast(bf16x8, z0), zb1 = __builtin_bit_cast(bf16x8, z1); \
            _Pragma("unroll") for (int jt = 0; jt < 4; ++jt) { f32x4 nv = {bf2f((bf16)(qw[2 * jt] & 0xffff)), bf2f((bf16)(qw[2 * jt] >> 16)), bf2f((bf16)(qw[2 * jt + 1] & 0xffff)), bf2f((bf16)(qw[2 * jt + 1] >> 16))}; \
                nv = MFMA16(P[jt][0], zb0, nv); nv = MFMA16(P[jt][1], zb1, nv); acc[jt] = nv; } \
            } while (0)
        RBC_READ(pa, qa, 0);
        for (int st = 0; st < nc; st += 2) { RBC_STEP(pa, qa, pb, qb, st); RBC_STEP(pb, qb, pa, qa, st + 1); }
#undef RBC_READ
#undef RBC_STEP
    } else if (w >= 1 && w <= 5) {
        const bool pl = w <= 4;
        const bf16* src = pl ? Pg + (16 * (w - 1) + fr) * 64 + 8 * fq : Qg + i * 64 + 16 * fq;
        const int src2 = pl ? 32 : 8;
        const int ldst = pl ? ((w - 1) * 2) * 1024 + lane * 16 : 8192 + lane * 16;
        v4u pipe[DL][2];
#pragma unroll
        for (int k = 0; k < DL; ++k) { const long o = off0 + (long)k * dstep; pipe[k][0] = *(const GAS v4u*)(src + o); pipe[k][1] = *(const GAS v4u*)(src + o + src2); }
#pragma unroll
        for (int k = 0; k < 2; ++k) {
            *(LAS v4u*)(B0 + k * BUFB + ldst) = pipe[k][0]; *(LAS v4u*)(B0 + k * BUFB + ldst + 1024) = pipe[k][1];
            const long o = off0 + (long)(DL + k) * dstep; pipe[k][0] = *(const GAS v4u*)(src + o); pipe[k][1] = *(const GAS v4u*)(src + o + src2); }
        __syncthreads();
        for (int st0 = 0; st0 < nc; st0 += DL) {
#pragma unroll
            for (int k = 0; k < DL; ++k) { const int st = st0 + k, kk = (k + 2) % DL; LAS unsigned char* Bn = B0 + ((st + 2) % 3) * BUFB;
                *(LAS v4u*)(Bn + ldst) = pipe[kk][0]; *(LAS v4u*)(Bn + ldst + 1024) = pipe[kk][1];
                const int sn = st + 2 + DL < nc ? st + 2 + DL : nc - 1; const long o = off0 + (long)sn * dstep;
                pipe[kk][0] = *(const GAS v4u*)(src + o); pipe[kk][1] = *(const GAS v4u*)(src + o + src2);
                RBC_BAR(); }
        }
    } else if (w == 6) {
        __syncthreads();
        for (int st = 0; st < nc; ++st) {
            if (st > 0) { const LAS unsigned char* Sp = B0 + S0OFF + ((st - 1) & 1) * 2048; const long o = off0 + (long)(st - 1) * dstep;
                *(GAS v4u*)(Sg + i * 64 + 16 * fq + o) = *(const LAS v4u*)(Sp + lane * 16); *(GAS v4u*)(Sg + i * 64 + 16 * fq + o + 8) = *(const LAS v4u*)(Sp + 1024 + lane * 16); }
            RBC_BAR();
        }
        { const long o = off0 + (long)(nc - 1) * dstep; const LAS unsigned char* Sp = B0 + S0OFF + ((nc - 1) & 1) * 2048;
            *(GAS v4u*)(Sg + i * 64 + 16 * fq + o) = *(const LAS v4u*)(Sp + lane * 16); *(GAS v4u*)(Sg + i * 64 + 16 * fq + o + 8) = *(const LAS v4u*)(Sp + 1024 + lane * 16); }
    } else { __syncthreads(); for (int st = 0; st < nc; ++st) RBC_BAR(); }
#undef RBC_BAR
}

constexpr int RC_WROW = 272, RC_WHEAD = 64 * RC_WROW + 512, RC_LDS0 = NWAVES * 8704;
static_assert(RC_LDS0 + 2 * RC_WHEAD <= LDSCTL_OFF, "R-C LDS map");
__device__ __forceinline__ void rc_stage(const Frame& F, const Args& a, int h0) {
    const bf16* Wg = (const bf16*)(a.ws + WS_WGU);
    for (int i = F.tid; i < 2 * 64 * 16; i += NTHR) { const int hh = i >> 10, row = (i >> 4) & 63, c8 = i & 15;
        *(LAS v4u*)(F.lds + RC_LDS0 + hh * RC_WHEAD + row * RC_WROW + c8 * 16) = *(const GAS v4u*)(Wg + (size_t)(64 * (h0 + hh) + row) * GLORA + 8 * c8); }
    if (F.tid < 256) { const int hh = F.tid >> 7, j = F.tid & 127; const float v = j < 64 ? a.in[I_LNXG][64 * (h0 + hh) + j] : a.in[I_LNXB][64 * (h0 + hh) + j - 64];
        *(LAS float*)(F.lds + RC_LDS0 + hh * RC_WHEAD + 64 * RC_WROW + j * 4) = v; }
}
__device__ __forceinline__ void rc_task(const Frame& F, const Args& a, int unit, int h, int tt) {
    const int lane = F.lane, fr = lane & 15, fq = lane >> 4, t = 16 * tt + fr;
    const int chr = 16 * (fr >> 2) + (fr & 3);
    const LAS unsigned char* wl = F.lds + RC_LDS0 + (F.wave >> 2) * RC_WHEAD;
    const bf16* Z = (const bf16*)(a.ws + WS_Z); bf16* MIX = (bf16*)(a.ws + WS_MIX);
    const bf16* zr = Z + (size_t)(unit * 64 + t) * DZ;
    bf16x8 sf[4], gA[2][2], sA[2][4][2]; v4u yl[2][2];
#pragma unroll
    for (int ks = 0; ks < 4; ++ks) sf[ks] = __builtin_bit_cast(bf16x8, *(const GAS v4u*)(zr + OFF_GD + 32 * ks + 8 * fq));
#pragma unroll
    for (int dir = 0; dir < 2; ++dir) {
        const size_t cu = ((size_t)unit * NH + h) * 2 + dir; const int pos = dir ? 63 - t : t;
        const bf16* Sg = (const bf16*)(a.ws + WS_RS) + cu * 4096; const bf16* Gg = (const bf16*)(a.ws + WS_RG) + cu * 4096; const bf16* Yg = (const bf16*)(a.ws + WS_RY) + cu * 4096;
        gA[dir][0] = *(const bf16x8*)(Gg + pos * 64 + 8 * fq); gA[dir][1] = *(const bf16x8*)(Gg + pos * 64 + 32 + 8 * fq);
#pragma unroll
        for (int it = 0; it < 4; ++it) { sA[dir][it][0] = *(const bf16x8*)(Sg + (chr + 4 * it) * 64 + 8 * fq); sA[dir][it][1] = *(const bf16x8*)(Sg + (chr + 4 * it) * 64 + 32 + 8 * fq); }
        yl[dir][0] = *(const GAS v4u*)(Yg + pos * 64 + 16 * fq); yl[dir][1] = *(const GAS v4u*)(Yg + pos * 64 + 16 * fq + 8);
    }
    asm volatile("" ::: "memory");
    f32x4 y[4], g[4];
#pragma unroll
    for (int it = 0; it < 4; ++it) { y[it] = (f32x4){0.f, 0.f, 0.f, 0.f}; g[it] = y[it]; }
#pragma unroll
    for (int dir = 0; dir < 2; ++dir)
#pragma unroll
        for (int it = 0; it < 4; ++it) {
            y[it] = MFMA16(sA[dir][it][0], gA[dir][0], y[it]); y[it] = MFMA16(sA[dir][it][1], gA[dir][1], y[it]);
            const unsigned w0 = yl[dir][it >> 1][2 * (it & 1)], w1 = yl[dir][it >> 1][2 * (it & 1) + 1];
            y[it] = y[it] + (f32x4){bf2f((bf16)(w0 & 0xffff)), bf2f((bf16)(w0 >> 16)), bf2f((bf16)(w1 & 0xffff)), bf2f((bf16)(w1 >> 16))}; }
    v4u vw[2];
    vw[0] = *(const GAS v4u*)(zr + OFF_V + 64 * h + 16 * fq); vw[1] = *(const GAS v4u*)(zr + OFF_V + 64 * h + 16 * fq + 8);
    const float bsum = ((const float*)(a.ws + WS_BONUS))[(size_t)(unit * 64 + t) * NH + h];
    asm volatile("" ::: "memory");
#pragma unroll
    for (int it = 0; it < 4; ++it)
#pragma unroll
        for (int ks = 0; ks < 4; ++ks) g[it] = MFMA16(*(const LAS bf16x8*)(wl + (chr + 4 * it) * RC_WROW + (32 * ks + 8 * fq) * 2), sf[ks], g[it]);
    float s1 = 0.f, s2 = 0.f;
#pragma unroll
    for (int it = 0; it < 4; ++it) {
        s1 += (y[it][0] + y[it][1]) + (y[it][2] + y[it][3]); s2 += (y[it][0] * y[it][0] + y[it][1] * y[it][1]) + (y[it][2] * y[it][2] + y[it][3] * y[it][3]); }
    s1 += __shfl_xor(s1, 16); s1 += __shfl_xor(s1, 32); s2 += __shfl_xor(s2, 16); s2 += __shfl_xor(s2, 32);
    const float mu = s1 * (1.f / 64.f), var = fmaxf(s2 * (1.f / 64.f) - mu * mu, 0.f), rs = rsqrtf(var + 64e-5f);
    unsigned ow[8];
#pragma unroll
    for (int it = 0; it < 4; ++it) {
        const unsigned v0 = vw[it >> 1][2 * (it & 1)], v1 = vw[it >> 1][2 * (it & 1) + 1];
        const f32x4 vv = {bf2f((bf16)(v0 & 0xffff)), bf2f((bf16)(v0 >> 16)), bf2f((bf16)(v1 & 0xffff)), bf2f((bf16)(v1 >> 16))};
        f32x4 o;
        const f32x4 lg = *(const LAS f32x4*)(wl + 64 * RC_WROW + (16 * fq + 4 * it) * 4), lb = *(const LAS f32x4*)(wl + 64 * RC_WROW + 256 + (16 * fq + 4 * it) * 4);
#pragma unroll
        for (int r = 0; r < 4; ++r) o[r] = ((y[it][r] - mu) * rs * lg[r] + lb[r] + bsum * vv[r]) * g[it][r];
        ow[2 * it] = pk2(o[0], o[1]); ow[2 * it + 1] = pk2(o[2], o[3]); }
    bf16* mo = MIX + (size_t)(unit * 64 + t) * D + 64 * h + 16 * fq;
    *(GAS v4u*)mo = (v4u){ow[0], ow[1], ow[2], ow[3]}; *(GAS v4u*)(mo + 8) = (v4u){ow[4], ow[5], ow[6], ow[7]};
}

__device__ __forceinline__ void tr_item(const float* W, int ldw, int K, int col0, bf16* WT, int row_off, LAS float* scr, int kb, int nb, int lane) {
    const int k0 = 64 * kb, n0 = 32 * nb;
#pragma unroll 8
    for (int i = 0; i < 32; ++i) { const int kk = 2 * i + (lane >> 5); scr[kk * 33 + (lane & 31)] = W[(size_t)(k0 + kk) * ldw + col0 + n0 + (lane & 31)]; }
    LDS_WAIT(); asm volatile("" ::: "memory");
    const int c = lane & 7;
#pragma unroll
    for (int j = 0; j < 4; ++j) { const int n = (lane >> 3) + 8 * j; const LAS float* s = scr + (8 * c) * 33 + n;
        v4u o; o.x = pk2(s[0 * 33], s[1 * 33]); o.y = pk2(s[2 * 33], s[3 * 33]); o.z = pk2(s[4 * 33], s[5 * 33]); o.w = pk2(s[6 * 33], s[7 * 33]);
        *(GAS v4u*)(WT + (size_t)(row_off + n0 + n) * K + k0 + 8 * c) = o; }
    LDS_WAIT(); asm volatile("" ::: "memory");
}
__device__ __forceinline__ void ffn_weight_copies(const Frame& F, const Args& a, int gw, int ngw) {
    LAS float* scr = (LAS float*)(F.lds + F.wave * 16384);
    constexpr int I_F1 = 16 * 128, I_F2 = 64 * 32;
    for (int it = gw; it < I_F1 + I_F2; it += ngw) {
        if (it < I_F1) tr_item(a.in[I_WFF1], DFF, D, 0, (bf16*)(a.ws + WS_WFF1), 0, scr, it / 128, it % 128, F.lane);
        else { const int r = it - I_F1; tr_item(a.in[I_WFF2], D, DFF, 0, (bf16*)(a.ws + WS_WFF2), 0, scr, r / 32, r % 32, F.lane); }
    }
}
__device__ __forceinline__ void p0_prologue(const Frame& F, const Args& a) {
    unsigned char* ws = a.ws;
    LAS float* scr = (LAS float*)(F.lds + F.wave * 16384);
    constexpr int NMODWG = MODW / 64;
    const bool split = F.G >= 2 * NMODWG;
    const int gw = split ? (F.bid - NMODWG) * NWAVES + F.wave : F.bid * NWAVES + F.wave, NGW = split ? (F.G - NMODWG) * NWAVES : F.G * NWAVES;
    constexpr int I_IN1 = 16 * 60, I_IN2 = 16 * 16, I_OUT = 16 * 32, I_GL = 8 * 16;
    constexpr int NITEMS = I_IN1 + I_IN2 + I_OUT + I_GL;
    for (int it = (gw >= 0 ? gw : NITEMS); it < NITEMS; it += NGW) {
        int r = it;
        if (r < I_IN1) { tr_item(a.in[I_WIN], DZW, D, 0, (bf16*)(ws + WS_WIN), 0, scr, r / 60, r % 60, F.lane); continue; } r -= I_IN1;
        if (r < I_IN2) { tr_item(a.in[I_WIN], DZW, D, 1920, (bf16*)(ws + WS_WIN), 2048, scr, r / 16, r % 16, F.lane); continue; } r -= I_IN2;
        if (r < I_OUT) { tr_item(a.in[I_WOUT], D, D, 0, (bf16*)(ws + WS_WOUT), 0, scr, r / 32, r % 32, F.lane); continue; } r -= I_OUT;
        tr_item(a.in[I_WGLU], DS, DS, 0, (bf16*)(ws + WS_WGLU), 0, scr, r / 16, r % 16, F.lane);
    }
    for (int i = F.bid * NTHR + F.tid; i < 128 * 1024 / 8; i += F.G * NTHR) ((GAS v4u*)(ws + WS_WIN + (size_t)1920 * D * 2))[i] = (v4u){0u, 0u, 0u, 0u};
    for (int i = F.bid * NTHR + F.tid; i < 64 * 512; i += F.G * NTHR) {
        const int r = i >> 9, dd = i & 511, f = dd & 255; const float omega = 1.0f / powf(10000.0f, (float)f * (1.0f / 256.0f)); const float ang = (float)r * omega;
        ((float*)(ws + WS_PE))[i] = dd < 256 ? sinf(ang) : cosf(ang);
    }
    p0_s5_tables(F, a);
    p0_lora(F, a);
    __syncthreads();
    {
        LAS float* sil = (LAS float*)F.lds;
        LAS float* part = (LAS float*)(F.lds + 16384);
        for (int i = F.tid; i < 3 * D; i += NTHR) { const int ci = i >> 10, k = i & 1023; const float cv = ci == 0 ? a.in[I_CCTX][k] : a.in[I_C][(ci - 1) * D + k]; sil[i] = cv * sigmoidf_(cv); }
        __syncthreads();
        for (int item = F.bid; item < MODW / 64; item += F.G) {
            const int n = item * 64 + F.lane; float a0 = 0.f, a1 = 0.f, a2 = 0.f;
            const float* wp = a.in[I_WADA] + (size_t)(F.wave * 128) * MODW + n;
#pragma unroll 32
            for (int k = 0; k < 128; ++k) { const float w = wp[(size_t)k * MODW]; const int kk = F.wave * 128 + k; a0 += sil[kk] * w; a1 += sil[1024 + kk] * w; a2 += sil[2048 + kk] * w; }
            part[(F.wave * 3 + 0) * 64 + F.lane] = a0; part[(F.wave * 3 + 1) * 64 + F.lane] = a1; part[(F.wave * 3 + 2) * 64 + F.lane] = a2;
            __syncthreads();
            if (F.tid < 192) { const int ci = F.tid >> 6, l = F.tid & 63; float s = a.in[I_BADA][item * 64 + l];
#pragma unroll
                for (int w = 0; w < 8; ++w) s += part[(w * 3 + ci) * 64 + l];
                ((float*)(ws + WS_MOD))[ci * MODW + item * 64 + l] = s; }
            __syncthreads();
        }
    }
}

__device__ __forceinline__ void p1_rows(const Frame& F, const Args& a) {
    const int gw = F.bid * NWAVES + F.wave, NGW = F.G * NWAVES;
    const float* pe = (const float*)(a.ws + WS_PE); const float* modb = (const float*)(a.ws + WS_MOD); bf16* XN = (bf16*)(a.ws + WS_XN);
    const bool pe_fixed = (NGW & 63) == 0; f32x4 pe2[2];
#pragma unroll
    for (int jj = 0; jj < 2; ++jj) pe2[jj] = ((const GAS f32x4*)(pe + (gw & 63) * 512 + jj * 256))[F.lane];
    for (int m0 = gw; m0 < M; m0 += 2 * NGW) {
        f32x4 v[2][4]; float ss[2] = {0.f, 0.f}; int mm[2]; mm[0] = m0; mm[1] = m0 + NGW < M ? m0 + NGW : m0;
#pragma unroll
        for (int q = 0; q < 2; ++q) { const int m = mm[q];
            const float* src = m < M_CTX ? a.in[I_XP] + (size_t)m * D : a.in[I_XS] + (size_t)(m - M_CTX) * D;
#pragma unroll
            for (int j = 0; j < 4; ++j) { v[q][j] = ((const GAS f32x4*)src)[F.lane + 64 * j];
                if (m >= M_CTX) { const int n = (m - M_CTX) & (LAT_T - 1);
                    if (j < 2 || !pe_fixed) { const int i = j < 2 ? (n >> 6) : (n & 63); const f32x4 pv = ((const GAS f32x4*)(pe + i * 512 + (j & 1) * 256))[F.lane]; v[q][j] = v[q][j] + pv; }
                    else v[q][j] = v[q][j] + pe2[j & 1]; }
                ss[q] += (v[q][j].x * v[q][j].x + v[q][j].y * v[q][j].y) + (v[q][j].z * v[q][j].z + v[q][j].w * v[q][j].w); } }
        const bool same = row_cond(mm[0]) == row_cond(mm[1]);
        f32x4 ga[4], sb[4];
        { const float* mod = modb + row_cond(mm[0]) * MODW;
#pragma unroll
            for (int j = 0; j < 4; ++j) { const f32x4 g = ((const GAS f32x4*)a.in[I_N1G])[F.lane + 64 * j], sc = ((const GAS f32x4*)(mod + 1 * D))[F.lane + 64 * j]; sb[j] = ((const GAS f32x4*)(mod + 0 * D))[F.lane + 64 * j]; ga[j] = g * (sc + 1.f); } }
#pragma unroll
        for (int q = 0; q < 2; ++q) { const int m = mm[q]; if (q == 1 && m == m0) break;
            if (q == 1 && !same) { const float* mod = modb + row_cond(m) * MODW;
#pragma unroll
                for (int j = 0; j < 4; ++j) { const f32x4 g = ((const GAS f32x4*)a.in[I_N1G])[F.lane + 64 * j], sc = ((const GAS f32x4*)(mod + 1 * D))[F.lane + 64 * j]; sb[j] = ((const GAS f32x4*)(mod + 0 * D))[F.lane + 64 * j]; ga[j] = g * (sc + 1.f); } }
            const float rs = rsqrtf(wave_sum(ss[q]) * (1.f / D) + 1e-6f);
#pragma unroll
            for (int j = 0; j < 4; ++j) {
                if (m >= M_CTX) ((GAS f32x4*)(a.out + (size_t)m * D))[F.lane + 64 * j] = v[q][j];
                const f32x4 h = v[q][j] * rs * ga[j] + sb[j];
                ((GAS unsigned long long*)(XN + (size_t)m * D))[F.lane + 64 * j] = (unsigned long long)pk2(h.x, h.y) | ((unsigned long long)pk2(h.z, h.w) << 32);
            } }
    }
}
__device__ __forceinline__ void p8_rows(const Frame& F, const Args& a) {
    const int gw = F.bid * NWAVES + F.wave, NGW = F.G * NWAVES;
    const float* modb = (const float*)(a.ws + WS_MOD); bf16* XN = (bf16*)(a.ws + WS_XN);
    for (int m = gw; m < M; m += NGW) {
        const int ci = row_cond(m); const float* mod = modb + ci * MODW;
        f32x4 v[4]; float ss = 0.f;
#pragma unroll
        for (int j = 0; j < 4; ++j) { v[j] = ((const GAS f32x4*)(a.out + (size_t)m * D))[F.lane + 64 * j]; ss += (v[j].x * v[j].x + v[j].y * v[j].y) + (v[j].z * v[j].z + v[j].w * v[j].w); }
        const float rs = rsqrtf(wave_sum(ss) * (1.f / D) + 1e-6f);
#pragma unroll
        for (int j = 0; j < 4; ++j) {
            const f32x4 g = ((const GAS f32x4*)a.in[I_N2G])[F.lane + 64 * j], sc = ((const GAS f32x4*)(mod + 4 * D))[F.lane + 64 * j], sh = ((const GAS f32x4*)(mod + 3 * D))[F.lane + 64 * j];
            const f32x4 h = v[j] * rs * g * (sc + 1.f) + sh;
            ((GAS unsigned long long*)(XN + (size_t)m * D))[F.lane + 64 * j] = (unsigned long long)pk2(h.x, h.y) | ((unsigned long long)pk2(h.z, h.w) << 32);
        }
    }
}
__device__ __forceinline__ void p11_rows(const Frame& F, const Args& a) {
    const int gw = F.bid * NWAVES + F.wave, NGW = F.G * NWAVES;
    for (int m = gw; m < M; m += NGW) {
        f32x4 v[4]; float ss = 0.f;
#pragma unroll
        for (int j = 0; j < 4; ++j) { v[j] = ((const GAS f32x4*)(a.out + (size_t)m * D))[F.lane + 64 * j]; ss += (v[j].x * v[j].x + v[j].y * v[j].y) + (v[j].z * v[j].z + v[j].w * v[j].w); }
        const float rs = rsqrtf(wave_sum(ss) * (1.f / D) + 1e-6f);
#pragma unroll
        for (int j = 0; j < 4; ++j) { const f32x4 g = ((const GAS f32x4*)a.in[I_NFG])[F.lane + 64 * j]; ((GAS f32x4*)(a.out + (size_t)m * D))[F.lane + 64 * j] = v[j] * rs * g; }
    }
}


#define XB_TMO      128
#define XB_XCNT(j)  (256  + 64 * (j))
#define XB_XSUB(j)  (1280 + 64 * (j))
#define XB_XGEN(j)  (2304 + 64 * (j))
#define XB_TOP      3328
#define XB_TOPGEN   3392
#define XCD_BAR_WORDS 3456
#define XB_SPIN_CAP (1u << 18)

__device__ __forceinline__ unsigned xb_ld(unsigned* p)              { return __hip_atomic_load(p, __ATOMIC_RELAXED, __HIP_MEMORY_SCOPE_AGENT); }
__device__ __forceinline__ unsigned xb_add(unsigned* p, unsigned v) { return __hip_atomic_fetch_add(p, v, __ATOMIC_RELAXED, __HIP_MEMORY_SCOPE_AGENT); }
__device__ __forceinline__ unsigned xb_xcc_id() { return (unsigned)__builtin_amdgcn_s_getreg((3 << 11) | 20) & 0xFu; }
#define XB_SPIN(cond, bar) do { unsigned _sp = 0; while (cond) { __builtin_amdgcn_s_sleep(1); \
    if ((++_sp & 255u) == 0u) { if (xb_ld(&(bar)[XB_TMO])) break; if (_sp > XB_SPIN_CAP) { atomicAdd(&(bar)[XB_TMO], 1u); break; } } } } while (0)

struct XcdBarrier {
    unsigned* bar; unsigned x;
    volatile LAS unsigned* st;
};

__device__ __forceinline__ XcdBarrier xcd_barrier_post(unsigned* bar, volatile LAS unsigned* st) {
    XcdBarrier b; b.bar = bar; b.x = xb_xcc_id(); b.st = st;
    if (threadIdx.x == 0) (void)xb_add(&bar[XB_XCNT(b.x)], 1u);
    return b;
}
__device__ __forceinline__ void xcd_barrier_complete(unsigned* bar, unsigned x, unsigned& nloc, unsigned& nx) {
    const unsigned G = gridDim.x * gridDim.y * gridDim.z;
    unsigned sum, cnt, mine, sp = 0u;
    for (;;) {
        sum = 0u; cnt = 0u; mine = 0u;
#pragma unroll
        for (unsigned j = 0; j < 16; ++j) { const unsigned c = xb_ld(&bar[XB_XCNT(j)]); sum += c; cnt += (c > 0u) ? 1u : 0u; mine = (j == x) ? c : mine; }
        if (sum == G) break;
        __builtin_amdgcn_s_sleep(1);
        if ((++sp & 255u) == 0u) { if (xb_ld(&bar[XB_TMO])) break; if (sp > XB_SPIN_CAP) { atomicAdd(&bar[XB_TMO], 1u); break; } }
    }
    nloc = mine > 0u ? mine : 1u; nx = cnt > 0u ? cnt : 1u;
}

__device__ __forceinline__ void xcd_barrier(const XcdBarrier& b) {
    asm volatile("s_waitcnt vmcnt(0)" ::: "memory");
    __syncthreads();
    if (threadIdx.x == 0) {
        unsigned* bar = b.bar;
        __builtin_amdgcn_s_waitcnt(0);
        unsigned nloc = b.st[0], nx = b.st[1];
        if (nloc == 0u) { xcd_barrier_complete(bar, b.x, nloc, nx); b.st[0] = nloc; b.st[1] = nx; }
        const unsigned old = xb_add(&bar[XB_XSUB(b.x)], 1u);
        const unsigned gen = old / nloc;
        if (old + 1u == (gen + 1u) * nloc) {
            __builtin_amdgcn_fence(__ATOMIC_RELEASE, "agent");
            asm volatile("s_waitcnt vmcnt(0)" ::: "memory");
            const unsigned og = xb_add(&bar[XB_TOP], 1u);
            const unsigned tg = og / nx;
            if (og + 1u == (tg + 1u) * nx) xb_add(&bar[XB_TOPGEN], 1u);
        }
        XB_SPIN(xb_ld(&bar[XB_TOPGEN]) == gen, bar);
        __builtin_amdgcn_fence(__ATOMIC_ACQUIRE, "agent");
        asm volatile("s_waitcnt vmcnt(0)" ::: "memory");
    }
    __syncthreads();
}


__global__ void __launch_bounds__(NTHR, 2) mk_fwd(Args args) {
    extern __shared__ __attribute__((aligned(16))) unsigned char lds[];
    Frame F; F.lds = (LAS unsigned char*)lds; F.tid = threadIdx.x; F.lane = F.tid & 63; F.wave = __builtin_amdgcn_readfirstlane(F.tid >> 6); F.G = gridDim.x; F.bid = blockIdx.x;
    unsigned char* ws = args.ws;
    const int lo = args.ph_lo, hi = args.ph_hi;
    for (int u = F.tid; u < (LDS_BYTES - LDSCTL_OFF) / 4; u += NTHR) ((LAS unsigned*)(F.lds + LDSCTL_OFF))[u] = 0u;
    __syncthreads();
    XcdBarrier bar = xcd_barrier_post((unsigned*)(ws + WS_CTL) + CW_BAR, (volatile LAS unsigned*)(F.lds + MISC_OFF) + 8);
#define IN(k) (lo <= (k) && (k) < hi)
#define SEAM(k) do { if (IN(k) && IN((k) + 1)) xcd_barrier(bar); } while (0)
    if (IN(0)) p0_prologue(F, args);
    SEAM(0);
    if (IN(1)) p1_rows(F, args);
    SEAM(1);
    if (IN(2)) {
        pg8::Gemm g{(const bf16*)(ws + WS_XN), (const bf16*)(ws + WS_WIN), M, DZ, D}; pg8::StaticOrder S; S.init(M, DZ, F.G, F.bid);
        pg8::EpiStore E{(bf16*)(ws + WS_Z), DZ, 2};
        pg8::gemm_phase<pg8::EpiStore, pg8::StaticOrder, true, true>(F.lds, g, S, E);
    }
    SEAM(2);
    if (IN(3)) {
        for (int i = F.bid * NWAVES + F.wave; i < NUNIT * NG; i += F.G * NWAVES) s5_unit<false>(F, args, i >> 5, i & 31);
        if ((F.G & 15) == 0 && (NUNIT * NH * 2) % (2 * F.G) == 0) {
            const int h = (F.bid >> 1) & 7, dir = F.bid & 1, u2 = F.wave >> 2;
            for (int i = F.bid + F.G * u2; i < NUNIT * NH * 2; i += 2 * F.G) ra2_unit(F, args, i >> 4, h, dir);
        }
    }
    SEAM(3);
    if (IN(4)) {
        if (F.bid < 128) { const int k = (F.bid & 7) * 4 + (F.bid >> 5); rb_latent_coop(F, args, CTX_B + (k >> 4), (k >> 1) & 7, k & 1, (F.bid >> 3) & 3); }
        else if (F.G == 256) { const int slot = (F.bid - 128) * NWAVES + F.wave;
            if (slot < LAT_B * 64) s5_pass_lat(F, args, slot * 64 + F.lane);
            { const int k = slot >> 2; rb_chain(F, args, k >> 4, (k >> 1) & 7, k & 1, slot & 3); }
            s5_pass_ctx(F, args, slot * 64 + F.lane); }
    }
    SEAM(4);
    if (IN(5)) {
        rc_stage(F, args, (2 * F.bid) & 7); __syncthreads();
        for (int i = F.bid * NWAVES + F.wave; i < NUNIT * NG; i += F.G * NWAVES) s5_unit<true>(F, args, i >> 5, i & 31);
        for (int i = F.bid * NWAVES + F.wave; i < NUNIT * NH * 4; i += F.G * NWAVES) rc_task(F, args, i >> 5, (i >> 2) & 7, i & 3);
    }
    SEAM(5);
    if (IN(6) && F.bid >= NGLU_WG && F.G > NGLU_WG) {
        ffn_weight_copies(F, args, (F.bid - NGLU_WG) * NWAVES + F.wave, (F.G - NGLU_WG) * NWAVES);
    }
    else if (IN(6)) {
        pg8::Gemm g{(const bf16*)(ws + WS_YS), (const bf16*)(ws + WS_WGLU), M, DS, DS}; pg8::StaticOrder S; S.init(M, DS, F.G, F.bid);
        pg8::EpiGlu E{(bf16*)(ws + WS_MIX), (const bf16*)(ws + WS_YS), args.in[I_BGLU]};
        pg8::gemm_phase<pg8::EpiGlu, pg8::StaticOrder, true, true>(F.lds, g, S, E);
    }
    SEAM(6);
    if (IN(7)) {
        pg8::Gemm g{(const bf16*)(ws + WS_MIX), (const bf16*)(ws + WS_WOUT), M, D, D}; pg8::StaticOrder S; S.init(M, D, F.G, F.bid, 192);
        pg8::RowStat R{(unsigned*)(ws + WS_XS), (unsigned*)(ws + WS_CTL) + CW_RS};
        pg8::EpiResidNorm<false, 3> E{args.out, (const float*)(ws + WS_MOD), args.in[I_N2G], (bf16*)(ws + WS_XN), R, args.in[I_XP]};
        pg8::gemm_phase<pg8::EpiResidNorm<false, 3>, pg8::StaticOrder, false, true, 3>(F.lds, g, S, E);
    }
    if (IN(7) && IN(9)) xcd_barrier(bar);
    if (IN(9)) {
        pg8::Gemm g{(const bf16*)(ws + WS_XN), (const bf16*)(ws + WS_WFF1), M, DFF, D}; pg8::StaticOrder S; S.init(M, DFF, F.G, F.bid);
        pg8::EpiStore E{(bf16*)(ws + WS_H), DFF, 1};
        pg8::gemm_phase<pg8::EpiStore, pg8::StaticOrder, true, true>(F.lds, g, S, E);
    }
    SEAM(9);
    if (IN(10)) {
        pg8::Gemm g{(const bf16*)(ws + WS_H), (const bf16*)(ws + WS_WFF2), M, D, DFF}; pg8::StaticOrder S; S.init(M, D, F.G, F.bid, 192);
        pg8::RowStat R{(unsigned*)(ws + WS_XS) + 65536, (unsigned*)(ws + WS_CTL) + CW_RS + 4096};
        pg8::EpiResidNorm<true, 3> E{args.out, (const float*)(ws + WS_MOD), args.in[I_NFG], nullptr, R, nullptr};
        pg8::gemm_phase<pg8::EpiResidNorm<true, 3>, pg8::StaticOrder, false, true, 3>(F.lds, g, S, E);
    }
#undef IN
#undef SEAM
}

extern "C" void kernel_launch(void* const* d_in, const int* in_sizes, int n_in, void* d_out, int out_size, void* d_ws, size_t ws_size, hipStream_t stream) {
    static int grid = 0;
    if (grid == 0) {
        int dev = 0, cus = 0, per_cu = 0;
        (void)hipGetDevice(&dev); (void)hipDeviceGetAttribute(&cus, hipDeviceAttributeMultiprocessorCount, dev);
        (void)hipFuncSetAttribute((const void*)mk_fwd, hipFuncAttributeMaxDynamicSharedMemorySize, LDS_BYTES);
        (void)hipOccupancyMaxActiveBlocksPerMultiprocessor(&per_cu, (const void*)mk_fwd, NTHR, LDS_BYTES);
        if (per_cu < 1) { fprintf(stderr, "kernel_launch: occupancy query says %d blocks per CU\n", per_cu); per_cu = 1; }
        if (per_cu > 1) per_cu = 1;
        grid = cus * per_cu;
        if (ws_size < WS_END) { fprintf(stderr, "kernel_launch: workspace too small (%zu)\n", ws_size); }
        if (grid != 256) fprintf(stderr, "kernel_launch: this kernel's phase maps assume 256 resident workgroups (256 CUs); got %d\n", grid);
    }
    Args a{};
    for (int i = 0; i < 36; ++i) a.in[i] = (const float*)d_in[i];
    a.out = (float*)d_out; a.ws = (unsigned char*)d_ws;
    (void)hipMemsetAsync((char*)d_ws + WS_CTL, 0, CTL_MEMSET_BYTES, stream);
    a.ph_lo = 0; a.ph_hi = 12;
    void* kargs[] = {&a};
    const hipError_t le = hipLaunchCooperativeKernel((const void*)mk_fwd, dim3(grid), dim3(NTHR), kargs, LDS_BYTES, stream);
    if (le != hipSuccess) fprintf(stderr, "kernel_launch: cooperative launch failed: %s (grid %d)\n", hipGetErrorString(le), grid);
}
```

```cpp
#include <hip/hip_runtime.h>
#include <cstdio>
#include <cstdint>
#include <math.h>
namespace pg8 {
#define PG8_LAS __attribute__((address_space(3)))
typedef unsigned short bf16_t;
typedef short bf16x8 __attribute__((ext_vector_type(8)));
typedef float f32x4 __attribute__((ext_vector_type(4)));
typedef unsigned u32x4 __attribute__((ext_vector_type(4)));
constexpr int BM = 256, BK = 64, HALF = 128, HTB = HALF * BK * 2  , STAGE_BYTES = 8 * HTB, NXCD = 8, WGM = 8;

__host__ __device__ __forceinline__ int lds_byte(int r, int c) { const int st = (r >> 4) * 2 + (c >> 5), rr = r & 15, cc = c & 31, ob = rr * 64 + cc * 2; return st * 1024 + (ob ^ (((ob >> 9) & 1) << 5)); }
__host__ __device__ __forceinline__ void stage_rc(int b, int& R, int& C) { const int st = b / 1024, sb = b % 1024, swz = sb ^ (((sb >> 9) & 1) << 5); R = (st >> 1) * 16 + swz / 64; C = (st & 1) * 32 + (swz % 64) / 2; }
__host__ __device__ __forceinline__ int perm32(int rho) { const int n = rho >> 4, i = rho & 15; return 8 * (i >> 2) + 4 * n + (i & 3); }

struct Unit { int pm, pn; };
struct Gemm { const bf16_t* A; const bf16_t* Bt; int M, N, K; };

struct StaticOrder {
    int nM, nN, nwg, G, c;
    __host__ __device__ void init(int M, int N, int G_, int c_, int bm = BM) { nM = M / bm; nN = N / BM; nwg = nM * nN; G = G_; c = c_; }
    __host__ __device__ bool next(int i, Unit& u) const {
        const long L = (long)i * G + c; if (L >= nwg) return false;
        int wgid = (int)L; { const int q = nwg / NXCD, r = nwg % NXCD, xcd = wgid % NXCD, off = wgid / NXCD; wgid = (xcd < r ? xcd * (q + 1) : r * (q + 1) + (xcd - r) * q) + off; }
        const int nig = WGM * nN, gid = wgid / nig, fm = gid * WGM, gsz = (nM - fm) < WGM ? (nM - fm) : WGM;
        u.pm = fm + ((wgid % nig) % gsz); u.pn = (wgid % nig) / gsz; return true;
    }
    __device__ __forceinline__ void a_ready(const Unit&) const {}
    __device__ __forceinline__ void done(const Unit&) const {}
};

__device__ __forceinline__ unsigned cvt_pk_bf16(float lo, float hi) { unsigned r; asm volatile("v_cvt_pk_bf16_f32 %0, %1, %2" : "=v"(r) : "v"(lo), "v"(hi)); return r; }
typedef float f32x2 __attribute__((ext_vector_type(2)));
__device__ __forceinline__ float bf2f(unsigned short u) { return __builtin_bit_cast(float, (unsigned)u << 16); }
struct EpiStore {
    static constexpr bool PERM = true, AFTER_DRAIN = false;
    bf16_t* O; int ldc; int act;
    __device__ __forceinline__ void operator()(const f32x4 (&acc)[2][2][4][2], const Unit& u, int wr, int wc, int fr, int fq) const {
        const int row0 = u.pm * BM + wr * 64 + fr, col0 = u.pn * BM + wc * 32 + 8 * fq;
#pragma unroll
        for (int ai = 0; ai < 2; ++ai)
#pragma unroll
            for (int m = 0; m < 4; ++m) { bf16_t* rowp = O + (size_t)(row0 + ai * HALF + m * 16) * ldc + col0;
#pragma unroll
                for (int bj = 0; bj < 2; ++bj) { f32x4 v0 = acc[ai][bj][m][0], v1 = acc[ai][bj][m][1];
                    if (act == 1) {
#pragma unroll
                        for (int e = 0; e < 4; ++e) { float a = v0[e] > 0.f ? v0[e] : 0.f, b = v1[e] > 0.f ? v1[e] : 0.f; v0[e] = a * a; v1[e] = b * b; } }
                    if (act == 2) { const int c = col0 + bj * HALF;
                        if (c >= 1536 && c < 1664) {
#pragma unroll
                            for (int e = 0; e < 4; ++e) { v0[e] = 1.f - 2.f * __builtin_amdgcn_rcpf(1.f + __expf(2.f * v0[e])); v1[e] = 1.f - 2.f * __builtin_amdgcn_rcpf(1.f + __expf(2.f * v1[e])); } }
                        else if (c >= 1792 && c < 1920) {
#pragma unroll
                            for (int e = 0; e < 4; ++e) { v0[e] = __builtin_amdgcn_rcpf(1.f + __expf(-v0[e])); v1[e] = __builtin_amdgcn_rcpf(1.f + __expf(-v1[e])); } } }
                    u32x4 w; w.x = cvt_pk_bf16(v0[0], v0[1]); w.y = cvt_pk_bf16(v0[2], v0[3]); w.z = cvt_pk_bf16(v1[0], v1[1]); w.w = cvt_pk_bf16(v1[2], v1[3]);
                    asm volatile("global_store_dwordx4 %0, %1, off sc1\n\ts_nop 1" :: "v"(rowp + bj * HALF), "v"(w) : "memory"); } }
    }
};
struct EpiResid {
    static constexpr bool PERM = true, AFTER_DRAIN = false;
    float* X; const float* mod; int goff;
    __device__ __forceinline__ void operator()(const f32x4 (&acc)[2][2][4][2], const Unit& u, int wr, int wc, int fr, int fq) const {
        const int row0 = u.pm * BM + wr * 64 + fr, col0 = u.pn * BM + wc * 32 + 8 * fq;
        const int ci = u.pm < 16 ? 0 : (u.pm < 32 ? 1 : 2);
        const float* g = mod + ci * 6144 + goff + col0;
        f32x4 gv[2][2];
#pragma unroll
        for (int bj = 0; bj < 2; ++bj)
#pragma unroll
            for (int n = 0; n < 2; ++n) gv[bj][n] = *(const f32x4*)(g + bj * HALF + 4 * n);
#pragma unroll
        for (int ai = 0; ai < 2; ++ai)
#pragma unroll
            for (int m = 0; m < 4; ++m) { float* rowp = X + (size_t)(row0 + ai * HALF + m * 16) * 1024 + col0;
#pragma unroll
                for (int bj = 0; bj < 2; ++bj)
#pragma unroll
                    for (int n = 0; n < 2; ++n) { f32x4* px = (f32x4*)(rowp + bj * HALF + 4 * n); f32x4 x = *px; x = x + gv[bj][n] * acc[ai][bj][m][n]; *px = x; } }
    }
};
template <int MR> struct EpiGlu {
    static constexpr bool PERM = true, AFTER_DRAIN = false;
    bf16_t* MIX; const bf16_t* YS; const float* bglu;
    __device__ __forceinline__ void operator()(const f32x4 (&acc)[2][2][4][2], const Unit& u, int wr, int wc, int fr, int fq) const {
        const int row0 = u.pm * 64 * MR + wr * 16 * MR + fr, col0 = u.pn * BM + wc * 32 + 8 * fq;
#pragma unroll
        for (int ai = 0; ai < 2; ++ai)
#pragma unroll
            for (int m = 0; m < MR; ++m) { const int row = row0 + ai * 32 * MR + m * 16;
#pragma unroll
                for (int bj = 0; bj < 2; ++bj) { const int col = col0 + bj * HALF;
                    const u32x4 yv = *(const u32x4*)(YS + (size_t)row * 512 + col);
                    const f32x4 b0 = *(const f32x4*)(bglu + col), b1 = *(const f32x4*)(bglu + col + 4);
                    float y[8]; y[0] = bf2f(yv.x & 0xffff); y[1] = bf2f(yv.x >> 16); y[2] = bf2f(yv.y & 0xffff); y[3] = bf2f(yv.y >> 16);
                    y[4] = bf2f(yv.z & 0xffff); y[5] = bf2f(yv.z >> 16); y[6] = bf2f(yv.w & 0xffff); y[7] = bf2f(yv.w >> 16);
                    float o[8];
#pragma unroll
                    for (int e = 0; e < 4; ++e) { o[e] = y[e] * __builtin_amdgcn_rcpf(1.f + __expf(-(acc[ai][bj][m][0][e] + b0[e]))); o[4 + e] = y[4 + e] * __builtin_amdgcn_rcpf(1.f + __expf(-(acc[ai][bj][m][1][e] + b1[e]))); }
                    u32x4 w; w.x = cvt_pk_bf16(o[0], o[1]); w.y = cvt_pk_bf16(o[2], o[3]); w.z = cvt_pk_bf16(o[4], o[5]); w.w = cvt_pk_bf16(o[6], o[7]);
                    *(u32x4*)(MIX + (size_t)row * 1024 + 512 + col) = w; } }
    }
};

struct RowStat { unsigned* xs; unsigned* cnt; };
template <int MR>
__device__ __forceinline__ void row_rs_exchange(const RowStat& R, const float (&ss)[2][4], const Unit& u, int wr, int wc, int fr, int fq, PG8_LAS unsigned char* lds) {
    PG8_LAS float* P = (PG8_LAS float*)lds; PG8_LAS float* S = P + 1024;
#pragma unroll
    for (int ai = 0; ai < 2; ++ai)
#pragma unroll
        for (int m = 0; m < MR; ++m) { float s = ss[ai][m]; s += __shfl_xor(s, 16); s += __shfl_xor(s, 32);
            if (fq == 0) P[(ai * 32 * MR + wr * 16 * MR + m * 16 + fr) * 4 + wc] = s; }
    __syncthreads();
    int tid = threadIdx.x; asm volatile("" : "+v"(tid));
    if (tid < 64 * MR) { const f32x4 p = *(const PG8_LAS f32x4*)(P + tid * 4); const float t = (p[0] + p[1]) + (p[2] + p[3]);
        __hip_atomic_store(R.xs + ((size_t)u.pm * 4 + u.pn) * 256 + tid, __builtin_bit_cast(unsigned, t), __ATOMIC_RELAXED, __HIP_MEMORY_SCOPE_AGENT); }
    asm volatile("s_waitcnt vmcnt(0)" ::: "memory");
    __syncthreads();
    if (tid == 0) {
        unsigned* c = R.cnt + 64 * u.pm;
        (void)__hip_atomic_fetch_add(c, 1u, __ATOMIC_RELAXED, __HIP_MEMORY_SCOPE_AGENT);
        unsigned sp = 0;
        while (__hip_atomic_load(c, __ATOMIC_RELAXED, __HIP_MEMORY_SCOPE_AGENT) < 4u) { __builtin_amdgcn_s_sleep(1); if (++sp > (1u << 22)) break; }
        __builtin_amdgcn_fence(__ATOMIC_ACQUIRE, "agent");
        asm volatile("s_waitcnt vmcnt(0)" ::: "memory");
    }
    __syncthreads();
    if (tid < 64 * MR) { float t = 0.f;
#pragma unroll
        for (int q = 0; q < 4; ++q) t += __builtin_bit_cast(float, __hip_atomic_load(R.xs + ((size_t)u.pm * 4 + q) * 256 + tid, __ATOMIC_RELAXED, __HIP_MEMORY_SCOPE_AGENT));
        S[tid] = rsqrtf(t * (1.0f / 1024.0f) + 1e-6f); }
    __syncthreads();
}
template <bool FINAL, int MR> struct EpiResidNorm {
    static constexpr bool PERM = true, AFTER_DRAIN = true;
    float* X; const float* mod; const float* ng; bf16_t* XN; RowStat R; const float* xp; const float* xs; const float* pe; const float* zr; bf16_t* X1B;
    __device__ __forceinline__ void operator()(const f32x4 (&)[2][2][4][2], const Unit&, int, int, int, int) const {}
    __device__ __forceinline__ void fused(f32x4 (&acc)[2][2][4][2], const Unit& u, int wr, int wc, int fr, int fq, PG8_LAS unsigned char* lds, int, int) const {
        const int rl0 = wr * 16 * MR + fr, col0 = u.pn * BM + wc * 32 + 8 * fq;
        float ss[2][4];
        {
            f32x4 xv[2][2], gv[2][2], pv[2][2]; u32x4 xw[2];
#define ERN_LOADH(buf, hh) do { const int g_ = (hh) >> 1, bj_ = (hh) & 1, ai_ = g_ / MR, m_ = g_ % MR; int rlo_ = rl0; asm volatile("" : "+v"(rlo_)); const int row_ = u.pm * 64 * MR + ai_ * 32 * MR + m_ * 16 + rlo_; \
                const int ci_ = row_ < 4096 ? 0 : (row_ < 8192 ? 1 : 2); const float* gp_ = mod + ci_ * 6144 + (FINAL ? 5 : 2) * 1024 + col0 + bj_ * HALF; \
                const float* sp_; \
                if (FINAL) { sp_ = nullptr; xw[buf] = *(const u32x4*)(X1B + (size_t)row_ * 1024 + col0 + bj_ * HALF); }     \
                else { sp_ = (row_ < 4096 ? xp + (size_t)row_ * 1024 : xs + (size_t)(row_ - 4096) * 1024) + col0 + bj_ * HALF; \
                    const int n_ = (row_ - 4096) & 4095, cc_ = (col0 + bj_ * HALF) & 511; const float* pp_ = row_ < 4096 ? zr + cc_ : pe + (size_t)(u.pn < 2 ? (n_ >> 6) : (n_ & 63)) * 512 + cc_; \
                    pv[buf][0] = *(const f32x4*)pp_; pv[buf][1] = *(const f32x4*)(pp_ + 4); } \
                if (!FINAL) { xv[buf][0] = *(const f32x4*)sp_; xv[buf][1] = *(const f32x4*)(sp_ + 4); } gv[buf][0] = *(const f32x4*)gp_; gv[buf][1] = *(const f32x4*)(gp_ + 4); } while (0)
            ERN_LOADH(0, 0);
#pragma unroll
            for (int hh = 0; hh < 4 * MR; ++hh) { const int g = hh >> 1, bj = hh & 1, ai = g / MR, m = g % MR;
                if (hh + 1 < 4 * MR) ERN_LOADH((hh + 1) & 1, hh + 1);
                asm volatile("" ::: "memory");
                int rlo = rl0; asm volatile("" : "+v"(rlo)); const int row = u.pm * 64 * MR + ai * 32 * MR + m * 16 + rlo; float* rowp = X + (size_t)row * 1024 + col0 + bj * HALF;
                float s = bj ? ss[ai][m] : 0.f;
                if (FINAL) { const u32x4 w_ = xw[hh & 1]; xv[hh & 1][0] = (f32x4){bf2f(w_.x & 0xffff), bf2f(w_.x >> 16), bf2f(w_.y & 0xffff), bf2f(w_.y >> 16)}; xv[hh & 1][1] = (f32x4){bf2f(w_.z & 0xffff), bf2f(w_.z >> 16), bf2f(w_.w & 0xffff), bf2f(w_.w >> 16)}; }
#pragma unroll
                for (int n = 0; n < 2; ++n) { f32x4 x = xv[hh & 1][n] + gv[hh & 1][n] * acc[ai][bj][m][n]; if (!FINAL) x = x + pv[hh & 1][n]; asm volatile("" : "+v"(x));
                    acc[ai][bj][m][n] = x;
                    s += (x[0] * x[0] + x[1] * x[1]) + (x[2] * x[2] + x[3] * x[3]); }
                ss[ai][m] = s;
                if (!FINAL) { const f32x4 x0_ = acc[ai][bj][m][0], x1_ = acc[ai][bj][m][1]; u32x4 w; w.x = cvt_pk_bf16(x0_[0], x0_[1]); w.y = cvt_pk_bf16(x0_[2], x0_[3]); w.z = cvt_pk_bf16(x1_[0], x1_[1]); w.w = cvt_pk_bf16(x1_[2], x1_[3]);
                    *(u32x4*)(X1B + (size_t)row * 1024 + col0 + bj * HALF) = w; } }
#undef ERN_LOADH
        }
        row_rs_exchange<MR>(R, ss, u, wr, wc, fr, fq, lds);
        PG8_LAS const float* S = (PG8_LAS const float*)lds + 1024;
        f32x4 ngv[4];
        asm volatile("" ::: "memory");
#pragma unroll
        for (int q = 0; q < 4; ++q) ngv[q] = *(const f32x4*)(ng + col0 + (q >> 1) * HALF + 4 * (q & 1));
        if (FINAL) {
#pragma unroll
            for (int g = 0; g < 2 * MR; ++g) { const int ai = g / MR, m = g % MR; int rlo = rl0; asm volatile("" : "+v"(rlo));
                const int rl = ai * 32 * MR + m * 16 + rlo, row = u.pm * 64 * MR + rl;
                const float rs = S[rl]; float* rowp = X + (size_t)row * 1024 + col0;
#pragma unroll
                for (int q = 0; q < 4; ++q) *(f32x4*)(rowp + (q >> 1) * HALF + 4 * (q & 1)) = acc[ai][q >> 1][m][q & 1] * rs * ngv[q];
                asm volatile("" ::: "memory"); }
        } else {
#pragma unroll
            for (int g = 0; g < 2 * MR; ++g) { const int ai = g / MR, m = g % MR; int rlo = rl0; asm volatile("" : "+v"(rlo));
                const int rl = ai * 32 * MR + m * 16 + rlo, row = u.pm * 64 * MR + rl; const int ci = row < 4096 ? 0 : (row < 8192 ? 1 : 2);
                const float rs = S[rl]; const float* md = mod + ci * 6144 + col0;
#pragma unroll
                for (int bj = 0; bj < 2; ++bj) {
                    const f32x4 h0 = acc[ai][bj][m][0] * rs * ngv[2 * bj] * (*(const f32x4*)(md + 4 * 1024 + bj * HALF) + 1.f) + *(const f32x4*)(md + 3 * 1024 + bj * HALF),
                                h1 = acc[ai][bj][m][1] * rs * ngv[2 * bj + 1] * (*(const f32x4*)(md + 4 * 1024 + bj * HALF + 4) + 1.f) + *(const f32x4*)(md + 3 * 1024 + bj * HALF + 4);
                    u32x4 w; w.x = cvt_pk_bf16(h0[0], h0[1]); w.y = cvt_pk_bf16(h0[2], h0[3]); w.z = cvt_pk_bf16(h1[0], h1[1]); w.w = cvt_pk_bf16(h1[2], h1[3]);
                    *(u32x4*)(XN + (size_t)row * 1024 + col0 + bj * HALF) = w; } }
        }
    }
};

template <class Epi, class Sched, bool ALIGN_EPI = false, bool SP2 = false, int MR = 4  >
__device__ __forceinline__ void gemm_phase(PG8_LAS unsigned char* lds, const Gemm g, const Sched& S, const Epi& E) {
    const int tid = threadIdx.x, wid = __builtin_amdgcn_readfirstlane(tid >> 6), lane = tid & 63, wr = wid >> 2, wc = wid & 3, fr = lane & 15, fq = lane >> 4;
    const int K = g.K, nt = K / BK;
    unsigned voffA[2], voffB[2];
#pragma unroll
    for (int i = 0; i < 2; ++i) { int R, C; stage_rc(tid * 16 + i * 8192, R, C); const int Rb = Epi::PERM ? ((R & ~31) + perm32(R & 31)) : R;
        const int Ra = MR == 4 ? R : (16 * MR) * (R >> 6) + ((R & 63) < 16 * MR ? (R & 63) : 16 * MR - 1);
        voffA[i] = (unsigned)(Ra * K + C) * 2u; voffB[i] = (unsigned)(Rb * K + C) * 2u; }
    const size_t kstep = (size_t)(BK * 2);
    const size_t hstep = (size_t)HALF * K * 2;
    const size_t tstep = 2 * hstep;
    const size_t hstepA = (size_t)(32 * MR) * K * 2, tstepA = 2 * hstepA;
    const unsigned ldsw = (unsigned)wid * 1024u;
    const int aoff = lds_byte(wr * 64 + fr, fq * 8), boff = lds_byte(wc * 32 + fr, fq * 8);
#define PG8_SA(b, h) (((b) * 2 + (h)) * HTB)
#define PG8_SB(b, h) ((4 + (b) * 2 + (h)) * HTB)
#define PG8_STAGE(bufoff, gbase, voff) do { _Pragma("unroll") for (int _i = 0; _i < 2; ++_i) \
        __builtin_amdgcn_global_load_lds((const unsigned*)((const char*)(gbase) + (voff)[_i]), (PG8_LAS unsigned*)(lds + (bufoff) + ldsw + _i * 8192), 16, 0, 0); } while (0)
#define PG8_LDA(dst, b, h) do { _Pragma("unroll") for (int m = 0; m < MR; ++m) _Pragma("unroll") for (int k = 0; k < 2; ++k) dst[m][k] = *(const PG8_LAS bf16x8*)(lds + PG8_SA(b, h) + aoff + m * 2048 + k * 1024); } while (0)
#define PG8_LDB(dst, b, h) do { _Pragma("unroll") for (int n = 0; n < 2; ++n) _Pragma("unroll") for (int k = 0; k < 2; ++k) dst[n][k] = *(const PG8_LAS bf16x8*)(lds + PG8_SB(b, h) + boff + n * 2048 + k * 1024); } while (0)
#define PG8_MMA(ai, bj, At, Bt) do { __builtin_amdgcn_s_setprio(1); _Pragma("unroll") for (int m = 0; m < MR; ++m) _Pragma("unroll") for (int n = 0; n < 2; ++n) _Pragma("unroll") for (int k = 0; k < 2; ++k) \
        acc[ai][bj][m][n] = __builtin_amdgcn_mfma_f32_16x16x32_bf16(Bt[n][k], At[m][k], acc[ai][bj][m][n], 0, 0, 0); __builtin_amdgcn_s_setprio(0); } while (0)
#define PG8_WAIT_V(n) asm volatile("s_waitcnt vmcnt(" #n ")" ::: "memory")
#define PG8_WAIT_L(n) asm volatile("s_waitcnt lgkmcnt(" #n ")" ::: "memory")
#define PG8_BAR __builtin_amdgcn_s_barrier()
#define PG8_SCHED __builtin_amdgcn_sched_barrier(0)
    Unit cur, nxt; int ui = 0;
    if (!S.next(0, cur)) return;
    f32x4 acc[2][2][4][2];
#pragma unroll
    for (int a = 0; a < 2; ++a)
#pragma unroll
        for (int b = 0; b < 2; ++b)
#pragma unroll
            for (int m = 0; m < 4; ++m)
#pragma unroll
                for (int n = 0; n < 2; ++n) acc[a][b][m][n] = (f32x4){0.f, 0.f, 0.f, 0.f};
    bf16x8 At[4][2], B0[2][2], B1[2][2];
    const char* cA = (const char*)g.A + (size_t)cur.pm * tstepA; const char* cB = (const char*)g.Bt + (size_t)cur.pn * tstep;
    S.a_ready(cur);
    if constexpr (SP2) {
        PG8_STAGE(PG8_SB(0, 0), cB, voffB); PG8_STAGE(PG8_SB(0, 1), cB + hstep, voffB); PG8_STAGE(PG8_SA(0, 0), cA, voffA); PG8_STAGE(PG8_SA(0, 1), cA + hstepA, voffA);
        if (wr == 1) PG8_BAR;
        PG8_WAIT_V(2); PG8_BAR;
        PG8_STAGE(PG8_SB(1, 0), cB + kstep, voffB); PG8_STAGE(PG8_SA(1, 0), cA + kstep, voffA); PG8_STAGE(PG8_SB(1, 1), cB + hstep + kstep, voffB);
        PG8_WAIT_V(6); PG8_BAR;
    } else {
        PG8_STAGE(PG8_SB(0, 0), cB, voffB); PG8_STAGE(PG8_SA(0, 0), cA, voffA); PG8_STAGE(PG8_SB(0, 1), cB + hstep, voffB); PG8_STAGE(PG8_SA(0, 1), cA + hstepA, voffA);
        if (wr == 1) PG8_BAR;
        PG8_WAIT_V(4); PG8_BAR;
        PG8_STAGE(PG8_SB(1, 0), cB + kstep, voffB); PG8_STAGE(PG8_SA(1, 0), cA + kstep, voffA); PG8_STAGE(PG8_SB(1, 1), cB + hstep + kstep, voffB);
        PG8_WAIT_V(6); PG8_BAR;
    }
    for (;;) {
        const bool has_next = S.next(ui + 1, nxt);
        const char* nA = has_next ? (const char*)g.A + (size_t)nxt.pm * tstepA : cA; const char* nB = has_next ? (const char*)g.Bt + (size_t)nxt.pn * tstep : cB;
        for (int t = 0; t < nt; t += 2) {
            const bool last = (t == nt - 2);
            const char* a1 = cA + (size_t)(t + 1) * kstep;
            const char* a2 = last ? nA : cA + (size_t)(t + 2) * kstep; const char* b2 = last ? nB : cB + (size_t)(t + 2) * kstep;
            const char* a3 = a2 + kstep; const char* b3 = b2 + kstep;
            if (last && has_next) S.a_ready(nxt);
            if constexpr (SP2) {
            PG8_LDB(B0, 0, 0); PG8_LDB(B1, 0, 1); PG8_SCHED; PG8_LDA(At, 0, 0); PG8_STAGE(PG8_SA(1, 1), a1 + hstepA, voffA);
            PG8_WAIT_V(8); PG8_WAIT_L(0); PG8_BAR; PG8_MMA(0, 0, At, B0); PG8_MMA(0, 1, At, B1); PG8_BAR; PG8_SCHED;
            PG8_LDA(At, 0, 1); PG8_STAGE(PG8_SB(0, 0), b2, voffB); PG8_STAGE(PG8_SB(0, 1), b2 + hstep, voffB); PG8_STAGE(PG8_SA(0, 0), a2, voffA);
            PG8_WAIT_V(8); PG8_WAIT_L(0); PG8_BAR; PG8_MMA(1, 0, At, B0); PG8_MMA(1, 1, At, B1); PG8_BAR; PG8_SCHED;
            PG8_LDB(B0, 1, 0); PG8_LDB(B1, 1, 1); PG8_SCHED; PG8_LDA(At, 1, 0); PG8_STAGE(PG8_SA(0, 1), a2 + hstepA, voffA);
            PG8_WAIT_V(8); PG8_WAIT_L(0); PG8_BAR; PG8_MMA(0, 0, At, B0); PG8_MMA(0, 1, At, B1); PG8_BAR; PG8_SCHED;
            PG8_LDA(At, 1, 1); PG8_STAGE(PG8_SB(1, 0), b3, voffB); PG8_STAGE(PG8_SB(1, 1), b3 + hstep, voffB); PG8_STAGE(PG8_SA(1, 0), a3, voffA);
            PG8_WAIT_V(8); PG8_WAIT_L(0); PG8_BAR; PG8_MMA(1, 0, At, B0); PG8_MMA(1, 1, At, B1); PG8_BAR; PG8_SCHED;
            } else {
            PG8_LDB(B0, 0, 0); PG8_SCHED; PG8_LDA(At, 0, 0); PG8_STAGE(PG8_SA(1, 1), a1 + hstepA, voffA);
            PG8_WAIT_L(8); PG8_BAR; PG8_WAIT_L(0); PG8_MMA(0, 0, At, B0); PG8_BAR; PG8_SCHED;
            PG8_LDB(B1, 0, 1); PG8_STAGE(PG8_SB(0, 0), b2, voffB);
            PG8_BAR; PG8_WAIT_L(0); PG8_MMA(0, 1, At, B1); PG8_BAR;
            PG8_LDA(At, 0, 1); PG8_STAGE(PG8_SA(0, 0), a2, voffA);
            PG8_BAR; PG8_WAIT_L(0); PG8_MMA(1, 0, At, B0); PG8_BAR; PG8_SCHED;
            PG8_STAGE(PG8_SB(0, 1), b2 + hstep, voffB);
            PG8_WAIT_V(6); PG8_BAR; PG8_MMA(1, 1, At, B1); PG8_BAR;
            PG8_LDB(B0, 1, 0); PG8_SCHED; PG8_LDA(At, 1, 0); PG8_STAGE(PG8_SA(0, 1), a2 + hstepA, voffA);
            PG8_WAIT_L(8); PG8_BAR; PG8_WAIT_L(0); PG8_MMA(0, 0, At, B0); PG8_BAR; PG8_SCHED;
            PG8_LDB(B1, 1, 1); PG8_STAGE(PG8_SB(1, 0), b3, voffB);
            PG8_BAR; PG8_WAIT_L(0); PG8_MMA(0, 1, At, B1); PG8_BAR;
            PG8_LDA(At, 1, 1); PG8_STAGE(PG8_SA(1, 0), a3, voffA);
            PG8_BAR; PG8_WAIT_L(0); PG8_MMA(1, 0, At, B0); PG8_BAR; PG8_SCHED;
            PG8_STAGE(PG8_SB(1, 1), b3 + hstep, voffB);
            PG8_WAIT_V(6); PG8_BAR; PG8_MMA(1, 1, At, B1); PG8_BAR;
            }
        }
        if constexpr (ALIGN_EPI) { if (wr == 0) PG8_BAR; }
        if constexpr (!Epi::AFTER_DRAIN) { E(acc, cur, wr, wc, fr, fq); S.done(cur); }
        if (!has_next) break;
#pragma unroll
        for (int a = 0; a < 2; ++a)
#pragma unroll
            for (int b = 0; b < 2; ++b)
#pragma unroll
                for (int m = 0; m < 4; ++m)
#pragma unroll
                    for (int n = 0; n < 2; ++n) acc[a][b][m][n] = (f32x4){0.f, 0.f, 0.f, 0.f};
        cur = nxt; cA = nA; cB = nB; ++ui;
        if constexpr (ALIGN_EPI) { if (wr == 1) PG8_BAR; }
    }
    PG8_WAIT_V(0);
    if constexpr (!ALIGN_EPI) { if (wr == 0) PG8_BAR; }
    PG8_BAR;
    if constexpr (Epi::AFTER_DRAIN) { E.fused(acc, cur, wr, wc, fr, fq, lds, wid, lane); S.done(cur); }
#undef PG8_SA
#undef PG8_SB
#undef PG8_STAGE
#undef PG8_LDA
#undef PG8_LDB
#undef PG8_MMA
#undef PG8_WAIT_V
#undef PG8_WAIT_L
#undef PG8_BAR
#undef PG8_SCHED
}
}

constexpr int NWAVES = 8, NTHR = 512;
constexpr int D = 1024, CTX_B = 16, CTX_T = 256, LAT_B = 2, LAT_T = 4096;
constexpr int M_CTX = CTX_B * CTX_T, M_LAT = LAT_B * LAT_T, M = M_CTX + M_LAT;
constexpr int NSEQ = CTX_B + LAT_B;
constexpr int DR = 512, HD = 64, NH = 8, LORA = 64, GLORA = 128, DS = 512, SG = 16, NG = 32, SP = 64, DFF = 4096, NMOD = 6, MODW = NMOD * D;
constexpr int DZW = 2432;
constexpr int DZ = 2560;
constexpr int OFF_R = 0, OFF_K = 512, OFF_V = 1024, OFF_WD = 1536, OFF_AD = 1664, OFF_GD = 1792, OFF_U = 2048;
__host__ __device__ inline int seq_T(int s) { return s < CTX_B ? CTX_T : LAT_T; }
__host__ __device__ inline int seq_row0(int s) { return s < CTX_B ? s * CTX_T : M_CTX + (s - CTX_B) * LAT_T; }
__device__ inline int row_cond(int m) { return m < M_CTX ? 0 : 1 + (m - M_CTX) / LAT_T; }

constexpr size_t MiB = 1u << 20;
constexpr size_t WS_CTL = 0, CTL_ZERO_BYTES = 1 * MiB, WS_END = 256 * MiB;
constexpr size_t WS_MOD = 1 * MiB;
constexpr size_t WS_PE = 1 * MiB + 128 * 1024;
constexpr size_t WS_WIN = 2 * MiB, WS_WOUT = 7 * MiB, WS_WFF1 = 9 * MiB, WS_WFF2 = 17 * MiB, WS_WGLU = 25 * MiB;
constexpr size_t WS_S5C = 1 * MiB + 256 * 1024, WS_S5BB = WS_S5C + 128 * 1024, WS_S5CT = WS_S5BB + 256 * 1024;
static_assert(WS_S5CT + 256 * 1024 <= 2 * MiB, "ws map");
constexpr size_t WS_XN = 26 * MiB;
constexpr size_t WS_MIX = 50 * MiB;
constexpr size_t WS_Z = 74 * MiB;
constexpr size_t WS_YS = 134 * MiB;
constexpr size_t WS_WDU = 25 * MiB + 512 * 1024, WS_WIU = WS_WDU + 128 * 1024, WS_WGU = WS_WIU + 128 * 1024;
static_assert(WS_WGU + 128 * 1024 <= WS_XN, "ws map");
constexpr size_t CHUNKB = (size_t)(M / 64) * NH * 2 * 8192;
constexpr size_t WS_RS = WS_XN;
constexpr size_t WS_RP = 146 * MiB, WS_RQ = WS_RP + CHUNKB, WS_RG = WS_RQ + CHUNKB, WS_RY = WS_RG + CHUNKB;
constexpr size_t WS_HLOC = WS_RY + CHUNKB, WS_HIN = WS_HLOC + 7 * MiB;
constexpr size_t WS_MODPART = 21 * MiB;
constexpr int CW_MOD = 3520;
constexpr size_t WS_HSEG = 9 * MiB;
static_assert(WS_HSEG + (size_t)(M / 64) * 64 * 4 * 64 * 4 <= WS_WFF2 + 8 * MiB, "ws map");
static_assert(WS_RS + CHUNKB <= WS_MIX && WS_YS + (size_t)M * DS * 2 <= WS_RP && WS_HIN + 7 * MiB <= WS_END, "ws map");
constexpr size_t WS_X1B = 176 * MiB;
static_assert(WS_X1B >= 74 * MiB + (size_t)M * DFF * 2 && WS_X1B + (size_t)M * D * 2 <= WS_HLOC, "ws map");
constexpr size_t WS_H = 74 * MiB;
static_assert(WS_H + (size_t)M * DFF * 2 <= WS_END, "ws map");

constexpr int LDS_BYTES = 153600;
constexpr int LDSCTL_OFF = 149504, MISC_OFF = LDSCTL_OFF + 320;
constexpr int CW_BAR = 0;
constexpr size_t CTL_MEMSET_BYTES = 65536;
constexpr int CW_RS = 4096;
constexpr size_t WS_BONUS = 640 * 1024;
constexpr size_t WS_XS = 128 * 1024;
static_assert((CW_RS + 2 * 4096) * 4 <= (int)CTL_MEMSET_BYTES && CTL_MEMSET_BYTES <= WS_XS && WS_XS + 2 * 262144 <= WS_BONUS && WS_BONUS + (size_t)12288 * 8 * 4 <= MiB, "control map");
#define GAS __attribute__((address_space(1)))
#define LAS __attribute__((address_space(3)))
typedef unsigned short bf16;
typedef unsigned v4u __attribute__((ext_vector_type(4)));
typedef float f32x4 __attribute__((ext_vector_type(4)));
#define LDS_WAIT() asm volatile("s_waitcnt lgkmcnt(0)" ::: "memory")
#define VM_WAIT() asm volatile("s_waitcnt vmcnt(0)" ::: "memory")
__device__ __forceinline__ unsigned f2bf(float f) { unsigned u = __builtin_bit_cast(unsigned, f); return (u + 0x7fffu + ((u >> 16) & 1u)) >> 16; }
typedef float f32x2_t __attribute__((ext_vector_type(2)));
typedef __bf16 bf16x2_t __attribute__((ext_vector_type(2)));
__device__ __forceinline__ unsigned pk2(float lo, float hi) { const f32x2_t v = {lo, hi}; const bf16x2_t b = __builtin_convertvector(v, bf16x2_t); return __builtin_bit_cast(unsigned, b); }
__device__ __forceinline__ float bf2f(bf16 u) { return __builtin_bit_cast(float, (unsigned)u << 16); }
__device__ __forceinline__ float sigmoidf_(float x) { return 1.f / (1.f + expf(-x)); }
__device__ __forceinline__ float frcp(float x) { return __builtin_amdgcn_rcpf(x); }
__device__ __forceinline__ float wave_sum(float v) {
#pragma unroll
    for (int o = 1; o < 64; o <<= 1) v += __shfl_xor(v, o);
    return v;
}

struct Args {
    const float* in[36];
    float* out; unsigned char* ws;
    int ph_lo, ph_hi;
};
enum { I_XP = 0, I_XS, I_C, I_CCTX, I_SRWKV, I_SRE, I_SIM, I_N1G, I_N2G, I_WADA, I_BADA, I_WIN, I_DBASE, I_WDUP, I_IBASE, I_WIUP, I_WGUP, I_KK, I_KA, I_RK, I_LNXG, I_LNXB,
       I_LRE, I_LIM, I_LDT, I_BRE, I_BIM, I_CRE, I_CIM, I_SSMD, I_WGLU, I_BGLU, I_WOUT, I_WFF1, I_WFF2, I_NFG };

struct Frame {
    LAS unsigned char* lds;
    int tid, lane, wave, G, bid;
};

typedef short bf16x8 __attribute__((ext_vector_type(8)));
typedef float f32x16 __attribute__((ext_vector_type(16)));
typedef float f32x2 __attribute__((ext_vector_type(2)));
constexpr int NGLU_WG = (M / 256) * (DS / 256);
constexpr int NUNIT = M / 64;
__device__ __forceinline__ void p0_s5_tables(const Frame& F, const Args& a, int tb, int TG) {
    float* S5C = (float*)(a.ws + WS_S5C); bf16* BB = (bf16*)(a.ws + WS_S5BB); bf16* CT = (bf16*)(a.ws + WS_S5CT);
    for (int t = tb * NTHR + F.tid; t < 2 * NG * SP * SG; t += TG * NTHR) {
        const int h = t & 15, i = t >> 4, p = i & 63, g = (i >> 6) & 31, dir = i >> 11;
        const float brf = a.in[I_BRE][(((size_t)dir * NG + g) * SP + p) * SG + h], bif = a.in[I_BIM][(((size_t)dir * NG + g) * SP + p) * SG + h];
        const float crf = a.in[I_CRE][(((size_t)dir * NG + g) * SG + h) * SP + p], cif = a.in[I_CIM][(((size_t)dir * NG + g) * SG + h) * SP + p];
        const float lref = a.in[I_LRE][g * SP + p], limf = a.in[I_LIM][g * SP + p], dtf = expf(a.in[I_LDT][dir * NG + g]);
        const float erf_ = expf(lref * dtf); float snf, csf; sincosf(limf * dtf, &snf, &csf);
        const double lre = lref, lim = limf, lbr = (double)(erf_ * csf), lbi = (double)(erf_ * snf);
        if (h == 0) {
            double pr = lbr, pi = lbi, p16r = 0.0, p16i = 0.0;
#pragma unroll
            for (int q = 0; q < 6; ++q) { const double nr = pr * pr - pi * pi, ni = 2.0 * pr * pi; pr = nr; pi = ni; if (q == 3) { p16r = pr; p16i = pi; } }
            float* cs = S5C + ((size_t)(dir * NG + g) * 6) * 64 + p;
            cs[0 * 64] = (float)lbr; cs[1 * 64] = (float)lbi; cs[2 * 64] = (float)p16r; cs[3 * 64] = (float)p16i;
            cs[4 * 64] = (float)pr; cs[5 * 64] = (float)pi;
        }
        const double nr = lbr - 1.0, ni = lbi, den = lre * lre + lim * lim; const double qr = (nr * lre + ni * lim) / den, qi = (ni * lre - nr * lim) / den;
        const double br = brf, bi = bif;
        BB[((((size_t)dir * NG + g) * 2 + 0) * 64 + p) * 16 + h] = (bf16)f2bf((float)(qr * br - qi * bi));
        BB[((((size_t)dir * NG + g) * 2 + 1) * 64 + p) * 16 + h] = (bf16)f2bf((float)(qr * bi + qi * br));
        CT[(((size_t)dir * NG + g) * 16 + h) * 128 + 2 * p + 0] = (bf16)f2bf(crf);
        CT[(((size_t)dir * NG + g) * 16 + h) * 128 + 2 * p + 1] = (bf16)f2bf(-cif);
    }
}
constexpr int S5T_DIR = 1536 + 4096 + 4352, S5T_LDS0 = 8 * 8704 + 2 * (64 * 272 + 512);
static_assert(S5T_LDS0 + 2 * S5T_DIR <= LDSCTL_OFF, "S5 table LDS map");
__device__ __forceinline__ void s5_stage(const Frame& F, const Args& a, int g) {
    const float* S5C = (const float*)(a.ws + WS_S5C); const bf16* BB = (const bf16*)(a.ws + WS_S5BB); const bf16* CT = (const bf16*)(a.ws + WS_S5CT);
    v4u tv[3];
#pragma unroll
    for (int q = 0; q < 3; ++q) { const int i = F.tid + q * NTHR; if (i < 2 * 608) { const int dir = i / 608, j = i % 608, dg = dir * NG + g;
            tv[q] = j < 96 ? *(const GAS v4u*)(S5C + (size_t)dg * 384 + j * 4) : (j < 352 ? *(const GAS v4u*)(BB + (size_t)dg * 2048 + (j - 96) * 8) : *(const GAS v4u*)(CT + (size_t)dg * 2048 + (j - 352) * 8)); } }
#pragma unroll
    for (int q = 0; q < 3; ++q) { const int i = F.tid + q * NTHR; if (i < 2 * 608) { const int dir = i / 608, j = i % 608; LAS unsigned char* T = F.lds + S5T_LDS0 + dir * S5T_DIR;
            if (j < 96) *(LAS v4u*)(T + j * 16) = tv[q];
            else if (j < 352) *(LAS v4u*)(T + 1536 + (j - 96) * 16) = tv[q];
            else { const int qq = j - 352; *(LAS v4u*)(T + 5632 + (qq >> 4) * 272 + (qq & 15) * 16) = tv[q]; } } }
}
struct S5Pre { bf16x8 afrP[2][2]; f32x2 hinP[2][2]; v4u hsP[2][2]; };
template <bool PC>
__device__ __forceinline__ void s5_load(const Frame& F, const Args& a, int unit, int g, S5Pre& P) {
    int lane_o = F.lane; asm volatile("" : "+v"(lane_o));
    const int lane = lane_o, cc = lane & 31, hh = lane >> 5;
    const bf16* Z = (const bf16*)(a.ws + WS_Z); const f32x2* HIN = (const f32x2*)(a.ws + WS_HIN); const unsigned* HSEG = (const unsigned*)(a.ws + WS_HSEG);
    const int rowbase = unit * 64;
    const int tau = 16 * ((cc >> 2) & 1) + (cc & 3) + 4 * (cc >> 3);
    {
#pragma unroll
        for (int dir = 0; dir < 2; ++dir)
#pragma unroll
            for (int k = 0; k < 2; ++k) { const int pos = 32 * k + tau, t = dir ? 63 - pos : pos; P.afrP[dir][k] = *(const bf16x8*)(Z + (size_t)(rowbase + t) * DZ + OFF_U + g * 16 + 8 * hh); }
        if (PC) {
#pragma unroll
            for (int dir = 0; dir < 2; ++dir)
#pragma unroll
                for (int pt = 0; pt < 2; ++pt) { const int dg = dir * NG + g; P.hinP[dir][pt] = HIN[((size_t)unit * 64 + dg) * 64 + 32 * pt + cc];
                    if (dir == 0) { const v4u* hq = (const v4u*)HSEG + (((size_t)unit * NG + g) * 64 + 32 * pt + cc) * 2; P.hsP[pt][0] = hq[0]; P.hsP[pt][1] = hq[1]; } }
        }
    }
}
template <bool PC>
__device__ __forceinline__ void s5_unit(const Frame& F, const Args& a, int unit, int g, const S5Pre& P) {
    const int lane = F.lane, cc = lane & 31, hh = lane >> 5;
    const bf16* Z = (const bf16*)(a.ws + WS_Z);
    f32x2* HLOC = (f32x2*)(a.ws + WS_HLOC); const f32x2* HIN = (const f32x2*)(a.ws + WS_HIN); bf16* YS = (bf16*)(a.ws + WS_YS);
    unsigned* HSEG = (unsigned*)(a.ws + WS_HSEG);
    const int rowbase = unit * 64;
    LAS unsigned char* hl = F.lds + F.wave * 8704;
    const int tau = 16 * ((cc >> 2) & 1) + (cc & 3) + 4 * (cc >> 3);
    {
        f32x4 yacc[2][2];
#pragma unroll
        for (int i = 0; i < 2; ++i)
#pragma unroll
            for (int j = 0; j < 2; ++j) yacc[i][j] = (f32x4){0.f, 0.f, 0.f, 0.f};
        const auto& afrP = P.afrP; const auto& hinP = P.hinP; const auto& hsP = P.hsP; v4u hsW[2]; unsigned short uP[2][2][4];
        if (PC) {
#pragma unroll
            for (int kn = 0; kn < 2; ++kn)
#pragma unroll
                for (int mt = 0; mt < 2; ++mt)
#pragma unroll
                    for (int i = 0; i < 4; ++i) uP[kn][mt][i] = Z[(size_t)(rowbase + 32 * kn + 16 * mt + 4 * (lane >> 4) + i) * DZ + OFF_U + g * 16 + (lane & 15)];
        }
        const float dskP = PC ? a.in[I_SSMD][g * 16 + (lane & 15)] : 0.f;
        asm volatile("" ::: "memory");
#pragma unroll
        for (int dir = 0; dir < 2; ++dir) {
            const int dg = dir * NG + g;
            const LAS unsigned char* T = F.lds + S5T_LDS0 + dir * S5T_DIR; const LAS float* cs = (const LAS float*)T;
            float lbr[2], lbi[2], l16r[2], l16i[2], cr[2], ci[2];
            bf16x8 bfr[2][2];
#pragma unroll
            for (int pt = 0; pt < 2; ++pt) {
                const int p = 32 * pt + cc;
                lbr[pt] = cs[p]; lbi[pt] = cs[64 + p]; l16r[pt] = cs[128 + p]; l16i[pt] = cs[192 + p];
                bfr[pt][0] = *(const LAS bf16x8*)(T + 1536 + (p * 16 + 8 * hh) * 2);
                bfr[pt][1] = *(const LAS bf16x8*)(T + 1536 + ((64 + p) * 16 + 8 * hh) * 2);
                if (PC) { const f32x2 h0 = hinP[dir][pt]; cr[pt] = h0.x; ci[pt] = h0.y; } else { cr[pt] = 0.f; ci[pt] = 0.f; }
            }
            bf16x8 cfr[4];
            if (PC) {
#pragma unroll
                for (int ks = 0; ks < 4; ++ks) cfr[ks] = *(const LAS bf16x8*)(T + 5632 + (lane & 15) * 272 + (32 * ks + 8 * (lane >> 4)) * 2);
            }
#pragma unroll
            for (int k = 0; k < 2; ++k) {
                const bf16x8 afr = afrP[dir][k];
#pragma unroll
                for (int pt = 0; pt < 2; ++pt) {
                    f32x16 xr = {0.f, 0.f, 0.f, 0.f, 0.f, 0.f, 0.f, 0.f, 0.f, 0.f, 0.f, 0.f, 0.f, 0.f, 0.f, 0.f}, xi = xr;
                    xr = __builtin_amdgcn_mfma_f32_32x32x16_bf16(afr, bfr[pt][0], xr, 0, 0, 0);
                    xi = __builtin_amdgcn_mfma_f32_32x32x16_bf16(afr, bfr[pt][1], xi, 0, 0, 0);
                    float e0r, e0i, e1r, e1i;
                    if (PC) { const unsigned w0 = hsP[pt][0][2 * dir + k], w1 = hsP[pt][1][2 * dir + k];
                        e0r = bf2f((bf16)(w0 & 0xffff)); e0i = bf2f((bf16)(w0 >> 16)); e1r = bf2f((bf16)(w1 & 0xffff)); e1i = bf2f((bf16)(w1 >> 16)); }
                    else {
                        float lr = 0.f, li = 0.f;
#pragma unroll
                        for (int q = 0; q < 16; ++q) { const float nr = __builtin_fmaf(lbr[pt], lr, __builtin_fmaf(-lbi[pt], li, xr[q])), ni = __builtin_fmaf(lbi[pt], lr, __builtin_fmaf(lbr[pt], li, xi[q])); lr = nr; li = ni; }
                        hsW[pt][2 * dir + k] = pk2(lr, li);
                        const float pr = __shfl_xor(lr, 32), pi = __shfl_xor(li, 32);
                        e0r = hh ? pr : lr; e0i = hh ? pi : li; e1r = hh ? lr : pr; e1i = hh ? li : pi; }
                    const float mr = l16r[pt] * cr[pt] - l16i[pt] * ci[pt] + e0r, mi = l16r[pt] * ci[pt] + l16i[pt] * cr[pt] + e0i;
                    float qr = hh ? mr : cr[pt], qi = hh ? mi : ci[pt];
                    cr[pt] = l16r[pt] * mr - l16i[pt] * mi + e1r; ci[pt] = l16r[pt] * mi + l16i[pt] * mr + e1i;
                    if (PC) {
#pragma unroll
                        for (int q = 0; q < 16; ++q) { const float nr = __builtin_fmaf(lbr[pt], qr, __builtin_fmaf(-lbi[pt], qi, xr[q])), ni = __builtin_fmaf(lbi[pt], qr, __builtin_fmaf(lbr[pt], qi, xi[q])); qr = nr; qi = ni;
                            *(LAS unsigned*)(hl + (16 * hh + q) * 272 + (32 * pt + cc) * 4) = pk2(qr, qi); }
                    }
                }
                if (PC) {
                    asm volatile("s_waitcnt lgkmcnt(0)" ::: "memory");
                    const int kn = dir ? 1 - k : k;
#pragma unroll
                    for (int mt = 0; mt < 2; ++mt) {
                        const int lrow = dir ? 31 - 16 * mt - (lane & 15) : 16 * mt + (lane & 15);
#pragma unroll
                        for (int ks = 0; ks < 4; ++ks) {
                            const bf16x8 hfr = *(const LAS bf16x8*)(hl + lrow * 272 + (32 * ks + 8 * (lane >> 4)) * 2);
                            if (kn == 0) yacc[0][mt] = __builtin_amdgcn_mfma_f32_16x16x32_bf16(hfr, cfr[ks], yacc[0][mt], 0, 0, 0);
                            else yacc[1][mt] = __builtin_amdgcn_mfma_f32_16x16x32_bf16(hfr, cfr[ks], yacc[1][mt], 0, 0, 0);
                        }
                    }
                    asm volatile("s_waitcnt lgkmcnt(0)" ::: "memory");
                }
            }
            if (!PC) { if (hh == 0) {
#pragma unroll
                for (int pt = 0; pt < 2; ++pt) HLOC[((size_t)unit * 64 + dg) * 64 + 32 * pt + cc] = (f32x2){cr[pt], ci[pt]}; } }
        }
        if (!PC) {
#pragma unroll
            for (int pt = 0; pt < 2; ++pt) ((v4u*)HSEG)[(((size_t)unit * NG + g) * 64 + 32 * pt + cc) * 2 + hh] = hsW[pt];
        }
        if (PC) {
            const int ho = lane & 15, qd = lane >> 4, ch = g * 16 + ho; const float dsk = dskP;
#pragma unroll
            for (int kn = 0; kn < 2; ++kn)
#pragma unroll
                for (int mt = 0; mt < 2; ++mt)
#pragma unroll
                    for (int i = 0; i < 4; ++i) {
                        const int row = rowbase + 32 * kn + 16 * mt + 4 * qd + i;
                        const float u = bf2f(uP[kn][mt][i]); const float y = yacc[kn][mt][i] + dsk * u;
                        const float zz = 1.5957691216057308f * (y + 0.044715f * y * y * y);
                        YS[(size_t)row * DS + ch] = (bf16)f2bf(y * frcp(1.f + __expf(-zz)));
                    }
        }
    }
}
__device__ __forceinline__ void s5_pass_ctx(const Frame& F, const Args& a, int ch) {
    const f32x2* HLOC = (const f32x2*)(a.ws + WS_HLOC); f32x2* HIN = (f32x2*)(a.ws + WS_HIN); const float* S5C = (const float*)(a.ws + WS_S5C);
    float* out_sre = a.out + (size_t)M * D + (size_t)CTX_B * 2 * NH * HD * HD; float* out_sim = out_sre + (size_t)CTX_B * 2 * NG * SP;
    const int s = ch >> 12, dgp = ch & 4095, dg = dgp >> 6, p = dgp & 63, dir = dg >> 5, unit0 = seq_row0(s) / 64;
    const float l64r = S5C[(size_t)dg * 384 + 256 + p], l64i = S5C[(size_t)dg * 384 + 320 + p];
    float hr = 0.f, hi = 0.f;
    f32x2 e[4];
#pragma unroll
    for (int j = 0; j < 4; ++j) { const int c = dir ? 3 - j : j; e[j] = HLOC[((size_t)(unit0 + c) * 64 + dg) * 64 + p]; }
#pragma unroll
    for (int j = 0; j < 4; ++j) { const int c = dir ? 3 - j : j; HIN[((size_t)(unit0 + c) * 64 + dg) * 64 + p] = (f32x2){hr, hi};
        const float nr = l64r * hr - l64i * hi + e[j].x, ni = l64r * hi + l64i * hr + e[j].y; hr = nr; hi = ni; }
    out_sre[(size_t)s * 4096 + dgp] = hr; out_sim[(size_t)s * 4096 + dgp] = hi;
}
__device__ __forceinline__ void s5_pass_lat(const Frame& F, const Args& a, int lc) {
    const f32x2* HLOC = (const f32x2*)(a.ws + WS_HLOC); f32x2* HIN = (f32x2*)(a.ws + WS_HIN); const float* S5C = (const float*)(a.ws + WS_S5C);
    const int b = lc >> 12, dgp = lc & 4095, dg = dgp >> 6, p = dgp & 63, dir = dg >> 5, unit0 = seq_row0(CTX_B + b) / 64;
    constexpr int nc = LAT_T / 64;
    const float l64r = S5C[(size_t)dg * 384 + 256 + p], l64i = S5C[(size_t)dg * 384 + 320 + p];
    float hr = a.in[I_SRE][(size_t)b * 4096 + dgp], hi = a.in[I_SIM][(size_t)b * 4096 + dgp];
    const f32x2* hl = HLOC + ((size_t)unit0 * 64 + dg) * 64 + p; f32x2* hn = HIN + ((size_t)unit0 * 64 + dg) * 64 + p;
    f32x2 e[nc];
#pragma unroll
    for (int j = 0; j < nc; ++j) { const int c = dir ? nc - 1 - j : j; e[j] = hl[(size_t)c * 4096]; }
#pragma unroll
    for (int j = 0; j < nc; ++j) { const int c = dir ? nc - 1 - j : j; hn[(size_t)c * 4096] = (f32x2){hr, hi};
        const float nr = l64r * hr - l64i * hi + e[j].x, ni = l64r * hi + l64i * hr + e[j].y; hr = nr; hi = ni; }
}

typedef short s16x4 __attribute__((ext_vector_type(4)));
typedef short v4i16_t __attribute__((ext_vector_type(4)));
typedef unsigned v2u __attribute__((ext_vector_type(2)));
namespace rw {
constexpr int RS = 144, MAT = 64 * RS;
constexpr int S_RM = 0, S_KM = 1, S_VM = 2, S_WD = 3, S_AD = 4, S_AT = 5, S_BT = 6, S_KT = 7, S_RT = 8, S_PB = 9, S_TA = 10, S_TB = 11, S_W1 = 12, S_UL = 13;
constexpr int S_AAK = 0, S_ARB = 1, S_ARK = 3, S_PA = 4, S_UZ = 0;
constexpr int LW_OFF = 9 * MAT, AA_OFF = LW_OFF + 64 * 272, SM_OFF = 14 * MAT;
static_assert(AA_OFF + 64 * 272 <= 13 * MAT && SM_OFF + 512 <= LDS_BYTES, "rwkv LDS map");
__device__ __forceinline__ s16x4 ldtr(const LAS unsigned char* p) { return __builtin_bit_cast(s16x4, __builtin_amdgcn_ds_read_tr16_b64_v4i16((LAS v4i16_t*)p)); }
__device__ __forceinline__ bf16x8 frag_d(const LAS unsigned char* Mx, int row, int ks, int fq) { return *(const LAS bf16x8*)(Mx + row * RS + (32 * ks + 8 * fq) * 2); }
__device__ __forceinline__ bf16x8 frag_t(const LAS unsigned char* Mx, int tile, int ks, int lane) {
    const int fq = lane >> 4, li = lane & 15;
    const LAS unsigned char* p = Mx + (32 * ks + 8 * fq + (li >> 2)) * RS + (16 * tile + 4 * (li & 3)) * 2;
    const s16x4 lo = ldtr(p), hi = ldtr(p + 4 * RS);
    return (bf16x8){lo.x, lo.y, lo.z, lo.w, hi.x, hi.y, hi.z, hi.w};
}
#define MFMA16(a, b, c) __builtin_amdgcn_mfma_f32_16x16x32_bf16(a, b, c, 0, 0, 0)
#define MFMA16K(a, b, c) __builtin_amdgcn_mfma_f32_16x16x16bf16_1k(a, b, c, 0, 0, 0)
template <bool XTR, bool YTR>
__device__ __forceinline__ void mm2(const LAS unsigned char* X, const LAS unsigned char* Y, int mt, int nt0, f32x4 (&acc)[2], int lane) {
#pragma unroll
    for (int ks = 0; ks < 2; ++ks) {
        const bf16x8 xb = XTR ? frag_t(X, mt, ks, lane) : frag_d(X, 16 * mt + (lane & 15), ks, lane >> 4);
#pragma unroll
        for (int e = 0; e < 2; ++e) { const bf16x8 ya = YTR ? frag_t(Y, nt0 + e, ks, lane) : frag_d(Y, 16 * (nt0 + e) + (lane & 15), ks, lane >> 4); acc[e] = MFMA16(ya, xb, acc[e]); }
    }
}
__device__ __forceinline__ void st4(LAS unsigned char* Mx, int m, int n, const f32x4 v) { *(LAS v2u*)(Mx + m * RS + n * 2) = (v2u){pk2(v[0], v[1]), pk2(v[2], v[3])}; }
__device__ __forceinline__ f32x4 ld4(const LAS unsigned char* Mx, int m, int n) { const v2u w = *(const LAS v2u*)(Mx + m * RS + n * 2);
    return (f32x4){bf2f((bf16)(w.x & 0xffff)), bf2f((bf16)(w.x >> 16)), bf2f((bf16)(w.y & 0xffff)), bf2f((bf16)(w.y >> 16))}; }
__device__ __forceinline__ void stg4(bf16* g, const f32x4 v) { *(GAS v2u*)g = (v2u){pk2(v[0], v[1]), pk2(v[2], v[3])}; }
}
__device__ __forceinline__ f32x4 ldg4bf(const bf16* g) { const v2u w = *(const GAS v2u*)g;
    return (f32x4){bf2f((bf16)(w.x & 0xffff)), bf2f((bf16)(w.x >> 16)), bf2f((bf16)(w.y & 0xffff)), bf2f((bf16)(w.y >> 16))}; }

__device__ __forceinline__ void p0_lora(const Frame& F, const Args& a, int tb, int TG) {
    bf16* WDU = (bf16*)(a.ws + WS_WDU); bf16* WIU = (bf16*)(a.ws + WS_WIU); bf16* WGU = (bf16*)(a.ws + WS_WGU);
    for (int i = tb * NTHR + F.tid; i < 2 * DR * LORA; i += TG * NTHR) { const int r = i & 63, c = (i >> 6) & 511, dir = i >> 15;
        WDU[i] = (bf16)f2bf(-1.4426950408889634f * a.in[I_WDUP][((size_t)dir * LORA + r) * DR + c]); WIU[i] = (bf16)f2bf(-1.4426950408889634f * a.in[I_WIUP][((size_t)dir * LORA + r) * DR + c]); }
    for (int i = tb * NTHR + F.tid; i < DR * GLORA; i += TG * NTHR) { const int r = i & 127, c = i >> 7; WGU[i] = (bf16)f2bf(a.in[I_WGUP][(size_t)r * DR + c]); }
}

struct RaConst { bf16x8 wb0, wb1; float base, kk8[8], kkc[2], kac[2]; };
struct RaPre { v4u x[3]; v4u f[8]; };
__device__ __forceinline__ void ra_consts(const Frame& F, const Args& a, int h, int dir, RaConst& C) {
    const int tid = F.tid, lane = F.lane, w = F.wave, fr = lane & 15, fq = lane >> 4;
    const int jt = w & 3, isA = w >> 2, c = 64 * h + 16 * jt + fr;
    const bf16* Wt = (const bf16*)(a.ws + (isA ? WS_WIU : WS_WDU)) + ((size_t)dir * DR + c) * LORA;
    C.wb0 = *(const bf16x8*)(Wt + 8 * fq); C.wb1 = *(const bf16x8*)(Wt + 32 + 8 * fq);
    C.base = a.in[isA ? I_IBASE : I_DBASE][dir * DR + c];
#pragma unroll
    for (int e = 0; e < 8; ++e) C.kk8[e] = a.in[I_KK][64 * h + 8 * (tid & 7) + e];
#pragma unroll
    for (int e = 0; e < 1; ++e) { const int j = tid >> 3; C.kkc[0] = a.in[I_KK][64 * h + j]; C.kac[0] = a.in[I_KA][64 * h + j]; C.kkc[1] = 0.f; C.kac[1] = 0.f; }
}
__device__ __forceinline__ void ra_prefetch(const Frame& F, const Args& a, int unit, int h, int dir, RaPre& Pf) {
    const int tid = F.tid, lane = F.lane, w = F.wave, fr = lane & 15, fq = lane >> 4;
    const bf16* Z = (const bf16*)(a.ws + WS_Z); const int rowbase = unit * 64;
    { const int tau = tid >> 3, c8 = tid & 7, tok = dir ? 63 - tau : tau; const bf16* zr = Z + (size_t)(rowbase + tok) * DZ + 64 * h + 8 * c8;
      Pf.x[0] = *(const GAS v4u*)(zr + OFF_R); Pf.x[1] = *(const GAS v4u*)(zr + OFF_K); Pf.x[2] = *(const GAS v4u*)(zr + OFF_V); }
    { const int isA = w >> 2; const int off = (isA ? OFF_AD : OFF_WD) + 64 * dir + 8 * fq;
#pragma unroll
      for (int tt = 0; tt < 4; ++tt) { const int tau = 16 * tt + fr, tok = dir ? 63 - tau : tau; const bf16* zr = Z + (size_t)(rowbase + tok) * DZ + off;
          Pf.f[2 * tt] = *(const GAS v4u*)zr; Pf.f[2 * tt + 1] = *(const GAS v4u*)(zr + 32); } }
}
__device__ __forceinline__ void ra_unit(const Frame& F, const Args& a, int unit, int h, int dir, const RaConst& C, RaPre& Pf, int next_unit) {
    using namespace rw;
    const int tid = F.tid, lane = F.lane, w = F.wave, fr = lane & 15, fq = lane >> 4;
    LAS unsigned char* L = F.lds;
    const int cu = (unit * NH + h) * 2 + dir;
    LAS float* rn = (LAS float*)(L + SM_OFF); LAS float* gC = rn + 64;
    __syncthreads();
    {
        const int tau = tid >> 3, c8 = tid & 7;
        { const unsigned* xp = (const unsigned*)&Pf.x[1]; float ss = 0.f;
#pragma unroll
          for (int e = 0; e < 4; ++e) { const float lo = bf2f((bf16)(xp[e] & 0xffff)) * C.kk8[2 * e], hi = bf2f((bf16)(xp[e] >> 16)) * C.kk8[2 * e + 1]; ss += lo * lo + hi * hi; }
          ss += __shfl_xor(ss, 1); ss += __shfl_xor(ss, 2); ss += __shfl_xor(ss, 4);
          if (c8 == 0) rn[tau] = frcp(fmaxf(sqrtf(ss), 1e-12f)); }
#pragma unroll
        for (int q = 0; q < 3; ++q) *(LAS v4u*)(L + q * MAT + tau * RS + 16 * (q < 2 ? ((c8 + (tau >> 3)) & 7) : c8)) = Pf.x[q];
    }
    {
        const int jt = w & 3, isA = w >> 2;
        LAS float* dst = (LAS float*)(L + (isA ? AA_OFF : LW_OFF)) + (16 * jt + fr) * 68;
#pragma unroll
        for (int tt = 0; tt < 4; ++tt) {
            v4u f0 = Pf.f[2 * tt], f1 = Pf.f[2 * tt + 1];
            if (!isA) { unsigned* p0 = (unsigned*)&f0; unsigned* p1 = (unsigned*)&f1;
#pragma unroll
                for (int e = 0; e < 4; ++e) { const float a0 = bf2f((bf16)(p0[e] & 0xffff)), a1 = bf2f((bf16)(p0[e] >> 16)), b0 = bf2f((bf16)(p1[e] & 0xffff)), b1 = bf2f((bf16)(p1[e] >> 16));
                    p0[e] = pk2(1.f - 2.f * frcp(1.f + __expf(2.f * a0)), 1.f - 2.f * frcp(1.f + __expf(2.f * a1))); p1[e] = pk2(1.f - 2.f * frcp(1.f + __expf(2.f * b0)), 1.f - 2.f * frcp(1.f + __expf(2.f * b1))); } }
            f32x4 acc = {0.f, 0.f, 0.f, 0.f};
            acc = MFMA16(__builtin_bit_cast(bf16x8, f0), C.wb0, acc); acc = MFMA16(__builtin_bit_cast(bf16x8, f1), C.wb1, acc);
            f32x4 o;
#pragma unroll
            for (int r = 0; r < 4; ++r) { const float sg = frcp(1.f + __expf(-(acc[r] + C.base))); o[r] = isA ? sg : -0.60653065971263342f * sg; }
            *(LAS f32x4*)(dst + 16 * tt + 4 * fq) = o;
        }
    }
    if (next_unit >= 0) ra_prefetch(F, a, next_unit, h, dir, Pf);
    __syncthreads();
    {
        const int j = tid >> 3, seg = tid & 7;
        const LAS float* lwp = (const LAS float*)(L + LW_OFF) + j * 68 + 8 * seg; const LAS float* aap = (const LAS float*)(L + AA_OFF) + j * 68 + 8 * seg;
        float lw[8], av[8], Lc[8];
        { const f32x4 x0 = *(const LAS f32x4*)lwp, x1 = *(const LAS f32x4*)(lwp + 4), y0 = *(const LAS f32x4*)aap, y1 = *(const LAS f32x4*)(aap + 4);
#pragma unroll
          for (int e = 0; e < 4; ++e) { lw[e] = x0[e]; lw[4 + e] = x1[e]; av[e] = y0[e]; av[4 + e] = y1[e]; } }
        float run = 0.f;
#pragma unroll
        for (int e = 0; e < 8; ++e) { run += lw[e]; Lc[e] = run; }
        float v = run;
#pragma unroll
        for (int d = 1; d < 8; d <<= 1) { const float t = __shfl_up(v, d, 8); if (seg >= d) v += t; }
        const float excl = v - run;
        const float kkc = C.kkc[0], kac = C.kac[0];
        float oa[8], ob[8], ok[8], orr[8];
#pragma unroll
        for (int e = 0; e < 8; ++e) {
            const int tau = 8 * seg + e; const float lc = Lc[e] + excl;
            const int so = tau * RS + 16 * (((j >> 3) + seg) & 7) + 2 * (j & 7);
            const float rr = bf2f(*(const LAS bf16*)(L + S_RM * MAT + so)), kk0 = bf2f(*(const LAS bf16*)(L + S_KM * MAT + so));
            const float kkn = kk0 * kkc * rn[tau];
            const float eL = __expf(lc), eLm = __expf(lc - lw[e]), inv = __expf(-lc);
            oa[e] = -kkn * eLm; ob[e] = kkn * av[e] * inv; ok[e] = kk0 * (1.f + (av[e] - 1.f) * kac) * inv; orr[e] = rr * eL;
            if (e == 7 && seg == 7) gC[j] = eL;
        }
        *(LAS v4u*)(L + S_AT * MAT + j * RS + 16 * seg) = (v4u){pk2(oa[0], oa[1]), pk2(oa[2], oa[3]), pk2(oa[4], oa[5]), pk2(oa[6], oa[7])};
        *(LAS v4u*)(L + S_BT * MAT + j * RS + 16 * seg) = (v4u){pk2(ob[0], ob[1]), pk2(ob[2], ob[3]), pk2(ob[4], ob[5]), pk2(ob[6], ob[7])};
        *(LAS v4u*)(L + S_KT * MAT + j * RS + 16 * seg) = (v4u){pk2(ok[0], ok[1]), pk2(ok[2], ok[3]), pk2(ok[4], ok[5]), pk2(ok[6], ok[7])};
        *(LAS v4u*)(L + S_RT * MAT + j * RS + 16 * seg) = (v4u){pk2(orr[0], orr[1]), pk2(orr[2], orr[3]), pk2(orr[4], orr[5]), pk2(orr[6], orr[7])};
    }
    __syncthreads();
    const int mt = w >> 1, nt0 = 2 * (w & 1), m = 16 * mt + fr;
    const f32x4 z4 = {0.f, 0.f, 0.f, 0.f};
    {
        f32x4 ab[2] = {z4, z4}, ak[2] = {z4, z4}, rb[2] = {z4, z4}, rk[2] = {z4, z4};
        mm2<true, true>(L + S_AT * MAT, L + S_BT * MAT, mt, nt0, ab, lane); mm2<true, true>(L + S_AT * MAT, L + S_KT * MAT, mt, nt0, ak, lane);
        mm2<true, true>(L + S_RT * MAT, L + S_BT * MAT, mt, nt0, rb, lane); mm2<true, true>(L + S_RT * MAT, L + S_KT * MAT, mt, nt0, rk, lane);
#pragma unroll
        for (int e = 0; e < 2; ++e) { const int n = 16 * (nt0 + e) + 4 * fq; f32x4 t1;
#pragma unroll
            for (int r = 0; r < 4; ++r) { const bool lo = (n + r) < m, le = (n + r) <= m; ab[e][r] = lo ? ab[e][r] : 0.f; ak[e][r] = lo ? ak[e][r] : 0.f; rb[e][r] = le ? rb[e][r] : 0.f; rk[e][r] = le ? rk[e][r] : 0.f;
                t1[r] = ab[e][r] + ((n + r) == m ? 1.f : 0.f); }
            st4(L + S_PA * MAT, m, n, ab[e]); st4(L + S_TA * MAT, m, n, t1); st4(L + S_AAK * MAT, m, n, ak[e]); st4(L + S_ARB * MAT, m, n, rb[e]); st4(L + S_ARK * MAT, m, n, rk[e]); }
    }
    __syncthreads();
    {
        f32x4 p1[2] = {z4, z4}, w1[2] = {z4, z4};
        mm2<false, true>(L + S_PA * MAT, L + S_PA * MAT, mt, nt0, p1, lane); mm2<false, true>(L + S_AAK * MAT, L + S_VM * MAT, mt, nt0, w1, lane);
#pragma unroll
        for (int e = 0; e < 2; ++e) { const int n = 16 * (nt0 + e) + 4 * fq; st4(L + S_PB * MAT, m, n, p1[e]); st4(L + S_W1 * MAT, m, n, w1[e]); }
    }
    __syncthreads();
#pragma unroll 1
    for (int it = 0; it < 4; ++it) {
        const LAS unsigned char* To = L + ((it & 1) ? S_TB : S_TA) * MAT; LAS unsigned char* Tn = L + ((it & 1) ? S_TA : S_TB) * MAT;
        const LAS unsigned char* Pc = L + ((it & 1) ? S_PA : S_PB) * MAT; LAS unsigned char* Pn = L + ((it & 1) ? S_PB : S_PA) * MAT;
        f32x4 tn[2], pn[2] = {z4, z4};
#pragma unroll
        for (int e = 0; e < 2; ++e) tn[e] = ld4(To, m, 16 * (nt0 + e) + 4 * fq);
        mm2<false, true>(To, Pc, mt, nt0, tn, lane); mm2<false, true>(Pc, Pc, mt, nt0, pn, lane);
#pragma unroll
        for (int e = 0; e < 2; ++e) { const int n = 16 * (nt0 + e) + 4 * fq; st4(Tn, m, n, tn[e]); st4(Pn, m, n, pn[e]); }
        __syncthreads();
    }
    {
        f32x4 tn[2];
#pragma unroll
        for (int e = 0; e < 2; ++e) tn[e] = ld4(L + S_TA * MAT, m, 16 * (nt0 + e) + 4 * fq);
        mm2<false, true>(L + S_TA * MAT, L + S_PB * MAT, mt, nt0, tn, lane);
#pragma unroll
        for (int e = 0; e < 2; ++e) st4(L + S_TB * MAT, m, 16 * (nt0 + e) + 4 * fq, tn[e]);
    }
    __syncthreads();
    {
        f32x4 uz[2] = {z4, z4}, ul[2] = {z4, z4};
        mm2<false, false>(L + S_TB * MAT, L + S_AT * MAT, mt, nt0, uz, lane); mm2<false, true>(L + S_TB * MAT, L + S_W1 * MAT, mt, nt0, ul, lane);
#pragma unroll
        for (int e = 0; e < 2; ++e) { const int n = 16 * (nt0 + e) + 4 * fq; st4(L + S_UZ * MAT, m, n, uz[e]); st4(L + S_UL * MAT, m, n, ul[e]); }
    }
    __syncthreads();
    {
        bf16* Pg = (bf16*)(a.ws + WS_RP) + (size_t)cu * 4096; bf16* Qg = (bf16*)(a.ws + WS_RQ) + (size_t)cu * 4096;
        bf16* Gg = (bf16*)(a.ws + WS_RG) + (size_t)cu * 4096; bf16* Yg = (bf16*)(a.ws + WS_RY) + (size_t)cu * 4096;
        f32x4 pp[2] = {z4, z4}, qq[2] = {z4, z4}, gg[2] = {z4, z4}, yy[2] = {z4, z4};
        mm2<false, true>(L + S_BT * MAT, L + S_UZ * MAT, mt, nt0, pp, lane);
        mm2<true, false>(L + S_UL * MAT, L + S_BT * MAT, mt, nt0, qq, lane); mm2<true, false>(L + S_VM * MAT, L + S_KT * MAT, mt, nt0, qq, lane);
        mm2<false, true>(L + S_ARB * MAT, L + S_UZ * MAT, mt, nt0, gg, lane);
        mm2<false, true>(L + S_ARB * MAT, L + S_UL * MAT, mt, nt0, yy, lane); mm2<false, true>(L + S_ARK * MAT, L + S_VM * MAT, mt, nt0, yy, lane);
        const float gm = gC[m];
#pragma unroll
        for (int e = 0; e < 2; ++e) { const int nt = nt0 + e, n = 16 * nt + 4 * fq;
            f32x4 po, qo, go;
#pragma unroll
            for (int r = 0; r < 4; ++r) { po[r] = gm * (pp[e][r] + ((n + r) == m ? 1.f : 0.f)); qo[r] = gC[n + r] * qq[e][r];
                go[r] = gg[e][r] + bf2f(*(const LAS bf16*)(L + S_RT * MAT + (n + r) * RS + 2 * m)); }
            stg4(Pg + m * 64 + 32 * (nt >> 1) + 8 * fq + 4 * (nt & 1), po);
            stg4(Qg + m * 64 + 16 * fq + 4 * nt, qo); stg4(Gg + m * 64 + 16 * fq + 4 * nt, go); stg4(Yg + m * 64 + n, yy[e]); }
    }
}

namespace rw {
constexpr int UNIT_LDS = 8 * MAT + 512;
constexpr int V_RM = 0, V_KM = 1, V_VM = 2, V_AT = 3, V_BT = 4, V_KT = 5, V_RT = 6, V_W1 = 7, V_PA = 0, V_PB = 1, V_UZ = 0, V_UL = 1, V_SM = 8 * MAT;
static_assert(2 * UNIT_LDS <= LDSCTL_OFF, "rwkv v2 LDS map");
}
constexpr int RA_KK_LDS = 2 * rw::UNIT_LDS;
static_assert(RA_KK_LDS + 512 <= LDSCTL_OFF, "rwkv v2 LDS map");
namespace rw {
__device__ __forceinline__ bf16x8 frag_tp(const LAS unsigned char* Mx, int tile, int ks, int lane) {
    const int fq = lane >> 4, li = lane & 15;
    const LAS unsigned char* p = Mx + (32 * ks + 4 * fq + (li >> 2)) * RS + (16 * tile + 4 * (li & 3)) * 2;
    const s16x4 lo = ldtr(p), hi = ldtr(p + 16 * RS);
    return (bf16x8){lo.x, lo.y, lo.z, lo.w, hi.x, hi.y, hi.z, hi.w};
}
__device__ __forceinline__ bf16x8 frag_dp(const LAS unsigned char* Mx, int row, int ks, int fq) {
    const v2u a = *(const LAS v2u*)(Mx + row * RS + (32 * ks + 4 * fq) * 2), b = *(const LAS v2u*)(Mx + row * RS + (32 * ks + 16 + 4 * fq) * 2);
    return __builtin_bit_cast(bf16x8, (v4u){a.x, a.y, b.x, b.y});
}
__device__ __forceinline__ s16x4 pk4(const f32x4 v) { return __builtin_bit_cast(s16x4, (v2u){pk2(v[0], v[1]), pk2(v[2], v[3])}); }
__device__ __forceinline__ bf16x8 xpack(const f32x4 lo, const f32x4 hi) { return __builtin_bit_cast(bf16x8, (v4u){pk2(lo[0], lo[1]), pk2(lo[2], lo[3]), pk2(hi[0], hi[1]), pk2(hi[2], hi[3])}); }
}
struct Ra2Const { bf16x8 wd0, wd1, wi0, wi1; float dbase, ibase, kkc, kac; };
struct Ra2Pre { v4u x[3][2]; };
struct Ra2Frag { v4u fd[8]; v4u fi[8]; };
__device__ __forceinline__ void ra2_consts(const Frame& F, const Args& a, int h, int dir, Ra2Const& C, int tid_o, int wv) {
    const int lane = tid_o & 63, fr = lane & 15, fq = lane >> 4, c = 64 * h + 16 * wv + fr;
    const bf16* Wd = (const bf16*)(a.ws + WS_WDU) + ((size_t)dir * DR + c) * LORA; const bf16* Wi = (const bf16*)(a.ws + WS_WIU) + ((size_t)dir * DR + c) * LORA;
    C.wd0 = *(const bf16x8*)(Wd + 8 * fq); C.wd1 = *(const bf16x8*)(Wd + 32 + 8 * fq); C.wi0 = *(const bf16x8*)(Wi + 8 * fq); C.wi1 = *(const bf16x8*)(Wi + 32 + 8 * fq);
    C.dbase = -1.4426950408889634f * a.in[I_DBASE][dir * DR + c]; C.ibase = -1.4426950408889634f * a.in[I_IBASE][dir * DR + c]; C.kkc = a.in[I_KK][c]; C.kac = a.in[I_KA][c];
}
__device__ __forceinline__ void ra2_prefetch(const Frame& F, const Args& a, int unit, int h, int dir, Ra2Pre& Pf, int tid_o) {
    const int tl = tid_o & 255;
    const bf16* Z = (const bf16*)(a.ws + WS_Z); const int rowbase = unit * 64;
    const int tau = tl >> 2, c4 = tl & 3, tok = dir ? 63 - tau : tau; const bf16* zr = Z + (size_t)(rowbase + tok) * DZ + 64 * h + 8 * c4;
#pragma unroll
    for (int q = 0; q < 3; ++q) { Pf.x[q][0] = *(const GAS v4u*)(zr + 512 * q); Pf.x[q][1] = *(const GAS v4u*)(zr + 512 * q + 32); }
}
__device__ __forceinline__ void ra2_frags(const Frame& F, const Args& a, int unit, int dir, Ra2Frag& Fg, int tid_o) {
    const int lane = tid_o & 63, fr = lane & 15, fq = lane >> 4;
    const bf16* Z = (const bf16*)(a.ws + WS_Z); const int rowbase = unit * 64;
#pragma unroll
    for (int tt = 0; tt < 4; ++tt) { const int tau = 16 * tt + fr, tok = dir ? 63 - tau : tau; const bf16* zr = Z + (size_t)(rowbase + tok) * DZ + 64 * dir + 8 * fq;
        Fg.fd[2 * tt] = *(const GAS v4u*)(zr + OFF_WD); Fg.fd[2 * tt + 1] = *(const GAS v4u*)(zr + OFF_WD + 32); Fg.fi[2 * tt] = *(const GAS v4u*)(zr + OFF_AD); Fg.fi[2 * tt + 1] = *(const GAS v4u*)(zr + OFF_AD + 32); }
}
__device__ __forceinline__ v4u tanh8(v4u x) { unsigned* p = (unsigned*)&x;
#pragma unroll
    for (int e = 0; e < 4; ++e) { const float a0 = bf2f((bf16)(p[e] & 0xffff)), a1 = bf2f((bf16)(p[e] >> 16)); p[e] = pk2(1.f - 2.f * frcp(1.f + __expf(2.f * a0)), 1.f - 2.f * frcp(1.f + __expf(2.f * a1))); }
    return x; }
__device__ __forceinline__ void ra2_unit(const Frame& F, const Args& a, int unit, int h, int dir, Ra2Pre& Pf, Ra2Frag& Fg, int next_unit) {
    using namespace rw;
    int tid_o = F.tid; asm volatile("" : "+v"(tid_o));
    const int lane = tid_o & 63, fr = lane & 15, fq = lane >> 4, tl = tid_o & 255;
    const int wv = (F.wave >> 2) ? 3 - (F.wave & 3) : (F.wave & 3);
    const int kmax = wv >> 1;
    LAS unsigned char* L = F.lds + (F.wave >> 2) * UNIT_LDS;
    LAS float* rn = (LAS float*)(L + V_SM); LAS float* gC = rn + 64;
    const int cu = (unit * NH + h) * 2 + dir, m = 16 * wv + fr;
    const f32x4 z4 = {0.f, 0.f, 0.f, 0.f};
    Ra2Const C; ra2_consts(F, a, h, dir, C, tid_o, wv);
    __syncthreads();
    {
        const int tau = tl >> 2, c4 = tl & 3; float ss = 0.f;
#pragma unroll
        for (int hf = 0; hf < 2; ++hf) { const unsigned* xp = (const unsigned*)&Pf.x[1][hf]; const LAS float* kkp = (const LAS float*)(F.lds + RA_KK_LDS) + 8 * c4 + 32 * hf;
#pragma unroll
            for (int e = 0; e < 4; ++e) { const float lo = bf2f((bf16)(xp[e] & 0xffff)) * kkp[2 * e], hi = bf2f((bf16)(xp[e] >> 16)) * kkp[2 * e + 1]; ss += lo * lo + hi * hi; } }
        ss += __shfl_xor(ss, 1); ss += __shfl_xor(ss, 2);
        if (c4 == 0) rn[tau] = frcp(fmaxf(sqrtf(ss), 1e-12f));
        if (dir == 0) {
            float bs = 0.f;
#pragma unroll
            for (int hf = 0; hf < 2; ++hf) { const unsigned* rp = (const unsigned*)&Pf.x[0][hf]; const unsigned* kp = (const unsigned*)&Pf.x[1][hf]; const LAS float* rkp = (const LAS float*)(F.lds + RA_KK_LDS) + 64 + 8 * c4 + 32 * hf;
#pragma unroll
                for (int e = 0; e < 4; ++e) bs += bf2f((bf16)(rp[e] & 0xffff)) * bf2f((bf16)(kp[e] & 0xffff)) * rkp[2 * e] + bf2f((bf16)(rp[e] >> 16)) * bf2f((bf16)(kp[e] >> 16)) * rkp[2 * e + 1]; }
            bs += __shfl_xor(bs, 1); bs += __shfl_xor(bs, 2);
            if (c4 == 0) ((float*)(a.ws + WS_BONUS))[(size_t)(unit * 64 + tau) * NH + h] = bs; }
#pragma unroll
        for (int q = 0; q < 3; ++q)
#pragma unroll
            for (int hf = 0; hf < 2; ++hf) *(LAS v4u*)(L + q * MAT + tau * RS + 16 * (c4 + 4 * hf)) = Pf.x[q][hf];
    }
    f32x4 lw4[4], av4[4];
#pragma unroll
    for (int tt = 0; tt < 4; ++tt) {
        const f32x4 db4 = {C.dbase, C.dbase, C.dbase, C.dbase}, ib4 = {C.ibase, C.ibase, C.ibase, C.ibase};
        f32x4 ad = MFMA16(__builtin_bit_cast(bf16x8, Fg.fd[2 * tt]), C.wd0, db4); ad = MFMA16(__builtin_bit_cast(bf16x8, Fg.fd[2 * tt + 1]), C.wd1, ad);
        f32x4 ai = MFMA16(__builtin_bit_cast(bf16x8, Fg.fi[2 * tt]), C.wi0, ib4); ai = MFMA16(__builtin_bit_cast(bf16x8, Fg.fi[2 * tt + 1]), C.wi1, ai);
#pragma unroll
        for (int r = 0; r < 4; ++r) { lw4[tt][r] = -0.87503878f   * frcp(1.f + __builtin_amdgcn_exp2f(ad[r])); av4[tt][r] = frcp(1.f + __builtin_amdgcn_exp2f(ai[r])); }
    }
    __syncthreads();
    {
        float base = 0.f;
#pragma unroll
        for (int tt = 0; tt < 4; ++tt) {
            const float p0 = lw4[tt][0], p1 = p0 + lw4[tt][1], p2 = p1 + lw4[tt][2], p3 = p2 + lw4[tt][3];
            const float s16 = __shfl_up(p3, 16), s32 = __shfl_up(p3, 32), s48 = __shfl_up(p3, 48);
            const float excl = (fq >= 1 ? s16 : 0.f) + (fq >= 2 ? s32 : 0.f) + (fq >= 3 ? s48 : 0.f);
            float tot = p3; tot += __shfl_xor(tot, 16); tot += __shfl_xor(tot, 32);
            const float pre[4] = {p0, p1, p2, p3};
            f32x4 oa, ob, ok, orr; float eL[4];
#pragma unroll
            for (int r = 0; r < 4; ++r) eL[r] = __builtin_amdgcn_exp2f(base + excl + pre[r]);
            const float ePrev = __builtin_amdgcn_exp2f(base + excl);
#pragma unroll
            for (int r = 0; r < 4; ++r) {
                const int tau = 16 * tt + 4 * fq + r;
                const float rr = bf2f(*(const LAS bf16*)(L + V_RM * MAT + tau * RS + 2 * m)), kk0 = bf2f(*(const LAS bf16*)(L + V_KM * MAT + tau * RS + 2 * m));
                const float kkn = kk0 * C.kkc * rn[tau], avv = av4[tt][r];
                const float eLm = r == 0 ? ePrev : eL[r > 0 ? r - 1 : 0], inv = frcp(eL[r]);
                oa[r] = -kkn * eLm; ob[r] = kkn * avv * inv; ok[r] = kk0 * (1.f + (avv - 1.f) * C.kac) * inv; orr[r] = rr * eL[r];
                if (tt == 3 && r == 3 && fq == 3) gC[m] = eL[r];
            }
            st4(L + V_AT * MAT, m, 16 * tt + 4 * fq, oa); st4(L + V_BT * MAT, m, 16 * tt + 4 * fq, ob); st4(L + V_KT * MAT, m, 16 * tt + 4 * fq, ok); st4(L + V_RT * MAT, m, 16 * tt + 4 * fq, orr);
            base += tot;
        }
    }
    __syncthreads();
    bf16x8 xAak[2], xArb[2], xArk[2]; f32x4 ab[4] = {z4, z4, z4, z4};
    {
        f32x4 ak[4] = {z4, z4, z4, z4}, rb[4] = {z4, z4, z4, z4}, rk[4] = {z4, z4, z4, z4};
#pragma unroll
        for (int ks = 0; ks < 2; ++ks) { const bf16x8 xa = frag_t(L + V_AT * MAT, wv, ks, lane), xr = frag_t(L + V_RT * MAT, wv, ks, lane);
#pragma unroll
            for (int nt = 0; nt < 4; ++nt) { if (nt > wv) continue;
                const bf16x8 yb = frag_t(L + V_BT * MAT, nt, ks, lane), yk = frag_t(L + V_KT * MAT, nt, ks, lane);
                ab[nt] = MFMA16(yb, xa, ab[nt]); ak[nt] = MFMA16(yk, xa, ak[nt]); rb[nt] = MFMA16(yb, xr, rb[nt]); rk[nt] = MFMA16(yk, xr, rk[nt]); } }
#pragma unroll
        for (int nt = 0; nt < 4; ++nt) { const int n = 16 * nt + 4 * fq;
            if (nt == wv) {
#pragma unroll
                for (int r = 0; r < 4; ++r) { const bool lo = (n + r) < m, le = (n + r) <= m; ab[nt][r] = lo ? ab[nt][r] : 0.f; ak[nt][r] = lo ? ak[nt][r] : 0.f; rb[nt][r] = le ? rb[nt][r] : 0.f; rk[nt][r] = le ? rk[nt][r] : 0.f; } }
            if (nt <= wv) st4(L + V_PA * MAT, m, n, ab[nt]); }
#pragma unroll
        for (int ks = 0; ks < 2; ++ks) { xAak[ks] = xpack(ak[2 * ks], ak[2 * ks + 1]); xArb[ks] = xpack(rb[2 * ks], rb[2 * ks + 1]); xArk[ks] = xpack(rk[2 * ks], rk[2 * ks + 1]); }
    }
    bf16x8 xT[2];
    {
        LAS unsigned char* ND = L + V_PB * MAT;
        const int dg = 16 * wv, troff = (4 * fq + (fr >> 2)) * RS + 8 * (fr & 3), wroff = fr * RS + 8 * fq;
        const LAS unsigned char* blkA = L + V_PA * MAT + dg * RS;
        LAS unsigned char* blkD = ND + dg * RS + dg * 2;
        f32x4 t, p;
        { const f32x4 ad = ld4(L + V_PA * MAT, m, dg + 4 * fq);
            const s16x4 ya = ldtr(blkA + dg * 2 + troff); p = MFMA16K(ya, pk4(ad), z4);
#pragma unroll
            for (int r = 0; r < 4; ++r) t[r] = ad[r] + ((4 * fq + r) == fr ? 1.f : 0.f); }
#pragma unroll
        for (int it = 0; it < 3; ++it) {
            const s16x4 xp = pk4(p);
            *(LAS s16x4*)(blkD + wroff) = xp; asm volatile("" ::: "memory");
            const s16x4 yp = ldtr(blkD + troff); asm volatile("" ::: "memory");
            t = MFMA16K(yp, pk4(t), t);
            if (it < 2) p = MFMA16K(yp, xp, z4);
        }
        const s16x4 xd = pk4(t);
        *(LAS s16x4*)(blkD + wroff) = xd;
        f32x4 n0 = z4, n1 = z4, n2 = z4;
        if (wv >= 1) { n0 = MFMA16K(ldtr(blkA + troff), xd, z4); *(LAS s16x4*)(ND + dg * RS + wroff) = pk4(n0); }
        if (wv >= 2) { n1 = MFMA16K(ldtr(blkA + 32 + troff), xd, z4); *(LAS s16x4*)(ND + dg * RS + 32 + wroff) = pk4(n1); }
        if (wv == 3) { n2 = MFMA16K(ldtr(blkA + 64 + troff), xd, z4); *(LAS s16x4*)(ND + dg * RS + 64 + wroff) = pk4(n2); }
        {
            f32x4 w1[4] = {z4, z4, z4, z4};
#pragma unroll
            for (int ks = 0; ks < 2; ++ks)
#pragma unroll
                for (int nt = 0; nt < 4; ++nt) { if (ks > kmax) continue; w1[nt] = MFMA16(frag_tp(L + V_VM * MAT, nt, ks, lane), xAak[ks], w1[nt]); }
#pragma unroll
            for (int nt = 0; nt < 4; ++nt) st4(L + V_W1 * MAT, m, 16 * nt + 4 * fq, w1[nt]);
        }
        __syncthreads();
        if (next_unit >= 0) { ra2_prefetch(F, a, next_unit, h, dir, Pf, tid_o); ra2_frags(F, a, next_unit, dir, Fg, tid_o); }
        f32x4 tp0 = n0, tp1 = n1;
        if (wv >= 2) { const s16x4 y10 = ldtr(ND + 16 * RS + troff);
            tp0 = MFMA16K(y10, pk4(n1), tp0);
            if (wv == 3) { tp0 = MFMA16K(ldtr(ND + 32 * RS + troff), pk4(n2), tp0);
                const f32x4 n21 = MFMA16K(ldtr(ND + 32 * RS + 32 + troff), pk4(n2), z4);
                tp0 = MFMA16K(y10, pk4(n21), tp0);
#pragma unroll
                for (int r = 0; r < 4; ++r) tp1[r] += n21[r]; } }
        v2u w0 = {0u, 0u}, w1_ = {0u, 0u}, w2 = {0u, 0u}, w3 = {0u, 0u}; const v2u wD = __builtin_bit_cast(v2u, xd);
        if (wv >= 1) w0 = __builtin_bit_cast(v2u, pk4(MFMA16K(ldtr(ND + troff), pk4(tp0), z4)));
        if (wv >= 2) w1_ = __builtin_bit_cast(v2u, pk4(MFMA16K(ldtr(ND + 16 * RS + 32 + troff), pk4(tp1), z4)));
        if (wv == 3) w2 = __builtin_bit_cast(v2u, pk4(MFMA16K(ldtr(ND + 32 * RS + 64 + troff), pk4(n2), z4)));
        if (wv == 0) w0 = wD;
        if (wv == 1) w1_ = wD;
        if (wv == 2) w2 = wD;
        if (wv == 3) w3 = wD;
        xT[0] = __builtin_bit_cast(bf16x8, (v4u){w0.x, w0.y, w1_.x, w1_.y}); xT[1] = __builtin_bit_cast(bf16x8, (v4u){w2.x, w2.y, w3.x, w3.y});
        f32x4 uz[4] = {z4, z4, z4, z4};
#pragma unroll
        for (int ks = 0; ks < 2; ++ks)
#pragma unroll
            for (int nt = 0; nt < 4; ++nt) { if (ks > kmax) continue; uz[nt] = MFMA16(frag_dp(L + V_AT * MAT, 16 * nt + fr, ks, fq), xT[ks], uz[nt]); }
#pragma unroll
        for (int nt = 0; nt < 4; ++nt) st4(L + V_UZ * MAT, m, 16 * nt + 4 * fq, uz[nt]);
    }
    __syncthreads();
    {
        f32x4 ul[4] = {z4, z4, z4, z4};
#pragma unroll
        for (int ks = 0; ks < 2; ++ks)
#pragma unroll
            for (int nt = 0; nt < 4; ++nt) { if (ks > kmax) continue; ul[nt] = MFMA16(frag_tp(L + V_W1 * MAT, nt, ks, lane), xT[ks], ul[nt]); }
#pragma unroll
        for (int nt = 0; nt < 4; ++nt) st4(L + V_UL * MAT, m, 16 * nt + 4 * fq, ul[nt]);
    }
    __syncthreads();
    {
        bf16* Pg = (bf16*)(a.ws + WS_RP) + (size_t)cu * 4096; bf16* Qg = (bf16*)(a.ws + WS_RQ) + (size_t)cu * 4096;
        bf16* Gg = (bf16*)(a.ws + WS_RG) + (size_t)cu * 4096; bf16* Yg = (bf16*)(a.ws + WS_RY) + (size_t)cu * 4096;
        f32x4 pp[4] = {z4, z4, z4, z4}, qq[4] = {z4, z4, z4, z4}, gg[4] = {z4, z4, z4, z4}, yy[4] = {z4, z4, z4, z4};
#pragma unroll
        for (int ks = 0; ks < 2; ++ks) {
            const bf16x8 xB = frag_d(L + V_BT * MAT, m, ks, fq), xUl = frag_t(L + V_UL * MAT, wv, ks, lane), xV = frag_t(L + V_VM * MAT, wv, ks, lane);
#pragma unroll
            for (int nt = 0; nt < 4; ++nt) {
                if (ks <= kmax) { gg[nt] = MFMA16(frag_tp(L + V_UZ * MAT, nt, ks, lane), xArb[ks], gg[nt]);
                    yy[nt] = MFMA16(frag_tp(L + V_UL * MAT, nt, ks, lane), xArb[ks], yy[nt]); yy[nt] = MFMA16(frag_tp(L + V_VM * MAT, nt, ks, lane), xArk[ks], yy[nt]); }
                pp[nt] = MFMA16(frag_t(L + V_UZ * MAT, nt, ks, lane), xB, pp[nt]);
                qq[nt] = MFMA16(frag_d(L + V_BT * MAT, 16 * nt + fr, ks, fq), xUl, qq[nt]); qq[nt] = MFMA16(frag_d(L + V_KT * MAT, 16 * nt + fr, ks, fq), xV, qq[nt]); }
        }
        const float gm = gC[m]; unsigned pw[8], qw[8], gw[8], yw[8];
#pragma unroll
        for (int nt = 0; nt < 4; ++nt) { const int n = 16 * nt + 4 * fq;
            f32x4 po, qo, go;
#pragma unroll
            for (int r = 0; r < 4; ++r) { po[r] = gm * (pp[nt][r] + ((n + r) == m ? 1.f : 0.f)); qo[r] = gC[n + r] * qq[nt][r];
                go[r] = gg[nt][r] + bf2f(*(const LAS bf16*)(L + V_RT * MAT + (n + r) * RS + 2 * m)); }
            pw[2 * nt] = pk2(po[0], po[1]); pw[2 * nt + 1] = pk2(po[2], po[3]); qw[2 * nt] = pk2(qo[0], qo[1]); qw[2 * nt + 1] = pk2(qo[2], qo[3]); gw[2 * nt] = pk2(go[0], go[1]); gw[2 * nt + 1] = pk2(go[2], go[3]);
            yw[2 * nt] = pk2(yy[nt][0], yy[nt][1]); yw[2 * nt + 1] = pk2(yy[nt][2], yy[nt][3]); }
        LAS unsigned char* st0 = L + V_AT * MAT + 16 * wv * RS; LAS unsigned char* st1 = L + V_W1 * MAT + 16 * wv * RS;
        const int wo = fr * RS, ro = (lane >> 3) * RS + (lane & 7) * 16; const int go_ = (16 * wv + (lane >> 3)) * 64 + (lane & 7) * 8;
        *(LAS v4u*)(st0 + wo + 16 * fq) = (v4u){pw[0], pw[1], pw[2], pw[3]}; *(LAS v4u*)(st0 + wo + 64 + 16 * fq) = (v4u){pw[4], pw[5], pw[6], pw[7]};
        *(LAS v4u*)(st1 + wo + 32 * fq) = (v4u){qw[0], qw[1], qw[2], qw[3]}; *(LAS v4u*)(st1 + wo + 32 * fq + 16) = (v4u){qw[4], qw[5], qw[6], qw[7]};
        asm volatile("" ::: "memory");
        { const v4u a0 = *(const LAS v4u*)(st0 + ro), a1 = *(const LAS v4u*)(st0 + ro + 8 * RS), b0 = *(const LAS v4u*)(st1 + ro), b1 = *(const LAS v4u*)(st1 + ro + 8 * RS);
            asm volatile("" ::: "memory");
            *(LAS v4u*)(st0 + wo + 32 * fq) = (v4u){gw[0], gw[1], gw[2], gw[3]}; *(LAS v4u*)(st0 + wo + 32 * fq + 16) = (v4u){gw[4], gw[5], gw[6], gw[7]};
#pragma unroll
            for (int nt = 0; nt < 4; ++nt) *(LAS v2u*)(st1 + wo + (16 * nt + 4 * fq) * 2) = (v2u){yw[2 * nt], yw[2 * nt + 1]};
            *(GAS v4u*)(Pg + go_) = a0; *(GAS v4u*)(Pg + go_ + 8 * 64) = a1; *(GAS v4u*)(Qg + go_) = b0; *(GAS v4u*)(Qg + go_ + 8 * 64) = b1; }
        asm volatile("" ::: "memory");
        { const v4u a0 = *(const LAS v4u*)(st0 + ro), a1 = *(const LAS v4u*)(st0 + ro + 8 * RS), b0 = *(const LAS v4u*)(st1 + ro), b1 = *(const LAS v4u*)(st1 + ro + 8 * RS);
            *(GAS v4u*)(Gg + go_) = a0; *(GAS v4u*)(Gg + go_ + 8 * 64) = a1; *(GAS v4u*)(Yg + go_) = b0; *(GAS v4u*)(Yg + go_ + 8 * 64) = b1; }
    }
}

__device__ __forceinline__ void rb_chain(const Frame& F, const Args& a, int s, int h, int dir, int wq) {
    const int lane = F.lane, fr = lane & 15, fq = lane >> 4, i = 16 * wq + fr;
    const int nc = seq_T(s) / 64, unit0 = seq_row0(s) / 64;
    const bf16* Pg = (const bf16*)(a.ws + WS_RP); const bf16* Qg = (const bf16*)(a.ws + WS_RQ); bf16* Sg = (bf16*)(a.ws + WS_RS);
    f32x4 acc[4];
    if (s >= CTX_B) { const float* s0 = a.in[I_SRWKV] + ((((size_t)(s - CTX_B) * 2 + dir) * NH + h) * HD + i) * HD;
#pragma unroll
        for (int jt = 0; jt < 4; ++jt) acc[jt] = *(const GAS f32x4*)(s0 + 16 * jt + 4 * fq); }
    else {
#pragma unroll
        for (int jt = 0; jt < 4; ++jt) acc[jt] = (f32x4){0.f, 0.f, 0.f, 0.f}; }
    bf16x8 pf[4][4][2]; v2u qv[4][4];
#define RB_LOAD(slot, st) do { const int c_ = dir ? nc - 1 - (st) : (st); const size_t cu_ = ((size_t)(unit0 + c_) * NH + h) * 2 + dir; \
        _Pragma("unroll") for (int jt = 0; jt < 4; ++jt) { pf[slot][jt][0] = *(const bf16x8*)(Pg + cu_ * 4096 + (16 * jt + fr) * 64 + 8 * fq); pf[slot][jt][1] = *(const bf16x8*)(Pg + cu_ * 4096 + (16 * jt + fr) * 64 + 32 + 8 * fq); \
            } { const v4u q0_ = *(const GAS v4u*)(Qg + cu_ * 4096 + i * 64 + 16 * fq), q1_ = *(const GAS v4u*)(Qg + cu_ * 4096 + i * 64 + 16 * fq + 8); \
            qv[slot][0] = (v2u){q0_.x, q0_.y}; qv[slot][1] = (v2u){q0_.z, q0_.w}; qv[slot][2] = (v2u){q1_.x, q1_.y}; qv[slot][3] = (v2u){q1_.z, q1_.w}; } } while (0)
#define RB_STEP(slot, st) do { const int c_ = dir ? nc - 1 - (st) : (st); const size_t cu_ = ((size_t)(unit0 + c_) * NH + h) * 2 + dir; \
        *(GAS v4u*)(Sg + cu_ * 4096 + i * 64 + 16 * fq) = (v4u){pk2(acc[0][0], acc[0][1]), pk2(acc[0][2], acc[0][3]), pk2(acc[1][0], acc[1][1]), pk2(acc[1][2], acc[1][3])}; \
        *(GAS v4u*)(Sg + cu_ * 4096 + i * 64 + 16 * fq + 8) = (v4u){pk2(acc[2][0], acc[2][1]), pk2(acc[2][2], acc[2][3]), pk2(acc[3][0], acc[3][1]), pk2(acc[3][2], acc[3][3])}; \
        bf16x8 zb[2]; _Pragma("unroll") for (int ks = 0; ks < 2; ++ks) { union { bf16x8 v; unsigned u[4]; } cv; cv.u[0] = pk2(acc[2 * ks][0], acc[2 * ks][1]); cv.u[1] = pk2(acc[2 * ks][2], acc[2 * ks][3]); \
            cv.u[2] = pk2(acc[2 * ks + 1][0], acc[2 * ks + 1][1]); cv.u[3] = pk2(acc[2 * ks + 1][2], acc[2 * ks + 1][3]); zb[ks] = cv.v; } \
        _Pragma("unroll") for (int jt = 0; jt < 4; ++jt) { f32x4 nv = {bf2f((bf16)(qv[slot][jt].x & 0xffff)), bf2f((bf16)(qv[slot][jt].x >> 16)), bf2f((bf16)(qv[slot][jt].y & 0xffff)), bf2f((bf16)(qv[slot][jt].y >> 16))}; \
            nv = MFMA16(pf[slot][jt][0], zb[0], nv); nv = MFMA16(pf[slot][jt][1], zb[1], nv); acc[jt] = nv; } } while (0)
    RB_LOAD(0, 0); RB_LOAD(1, 1); RB_LOAD(2, 2); RB_LOAD(3, 3);
    for (int st = 0; st < nc; st += 4) {
        const int n4 = st + 4 < nc ? st + 4 : nc - 1, n5 = st + 5 < nc ? st + 5 : nc - 1, n6 = st + 6 < nc ? st + 6 : nc - 1, n7 = st + 7 < nc ? st + 7 : nc - 1;
        RB_STEP(0, st);     RB_LOAD(0, n4);
        RB_STEP(1, st + 1); RB_LOAD(1, n5);
        RB_STEP(2, st + 2); RB_LOAD(2, n6);
        RB_STEP(3, st + 3); RB_LOAD(3, n7);
    }
#undef RB_LOAD
#undef RB_STEP
    if (s < CTX_B) { float* so = a.out + (size_t)M * D + ((((size_t)s * 2 + dir) * NH + h) * HD + i) * HD;
#pragma unroll
        for (int jt = 0; jt < 4; ++jt) *(GAS f32x4*)(so + 16 * jt + 4 * fq) = acc[jt]; }
}

__device__ __forceinline__ void rb_latent_coop(const Frame& F, const Args& a, int s, int h, int dir, int wq) {
    const int lane = F.lane, fr = lane & 15, fq = lane >> 4, i = 16 * wq + fr, w = F.wave;
    constexpr int nc = LAT_T / 64, DL = 16;
    const int unit0 = seq_row0(s) / 64;
    const bf16* Pg = (const bf16*)(a.ws + WS_RP); const bf16* Qg = (const bf16*)(a.ws + WS_RQ); bf16* Sg = (bf16*)(a.ws + WS_RS);
    const long dstep = dir ? -65536 : 65536;
    const long off0 = ((long)((unit0 * NH + h) * 2 + dir) + 16 * (dir ? nc - 1 : 0)) * 4096;
    LAS unsigned char* B0 = F.lds; constexpr int BUFB = 10240, S0OFF = 3 * BUFB;
#define RBC_BAR() do { asm volatile("s_waitcnt lgkmcnt(0)" ::: "memory"); __builtin_amdgcn_s_barrier(); asm volatile("" ::: "memory"); } while (0)
    if (w == 0) {
        f32x4 acc[4];
        { const float* s0 = a.in[I_SRWKV] + ((((size_t)(s - CTX_B) * 2 + dir) * NH + h) * HD + i) * HD;
#pragma unroll
            for (int jt = 0; jt < 4; ++jt) acc[jt] = *(const GAS f32x4*)(s0 + 16 * jt + 4 * fq); }
        __syncthreads();
        bf16x8 pa[4][2], pb[4][2]; v4u qa[2], qb[2];
#define RBC_READ(P, Q, stp) do { const LAS unsigned char* Bi_ = B0 + ((stp) % 3) * BUFB; \
            _Pragma("unroll") for (int jt = 0; jt < 4; ++jt) { P[jt][0] = *(const LAS bf16x8*)(Bi_ + (jt * 2) * 1024 + lane * 16); P[jt][1] = *(const LAS bf16x8*)(Bi_ + (jt * 2 + 1) * 1024 + lane * 16); } \
            Q[0] = *(const LAS v4u*)(Bi_ + 8192 + lane * 16); Q[1] = *(const LAS v4u*)(Bi_ + 8192 + 1024 + lane * 16); } while (0)
#define RBC_STEP(P, Q, PN, QN, stp) do { \
            const v4u z0 = (v4u){pk2(acc[0][0], acc[0][1]), pk2(acc[0][2], acc[0][3]), pk2(acc[1][0], acc[1][1]), pk2(acc[1][2], acc[1][3])}, z1 = (v4u){pk2(acc[2][0], acc[2][1]), pk2(acc[2][2], acc[2][3]), pk2(acc[3][0], acc[3][1]), pk2(acc[3][2], acc[3][3])}; \
            *(LAS v4u*)(B0 + S0OFF + ((stp) & 1) * 2048 + lane * 16) = z0; *(LAS v4u*)(B0 + S0OFF + ((stp) & 1) * 2048 + 1024 + lane * 16) = z1;     \
            asm volatile("" ::: "memory"); \
            RBC_READ(PN, QN, (stp) + 1);                                                                                                                  \
            asm volatile("s_waitcnt lgkmcnt(10)\n\ts_barrier" ::: "memory");     \
            const unsigned qw[8] = {Q[0].x, Q[0].y, Q[0].z, Q[0].w, Q[1].x, Q[1].y, Q[1].z, Q[1].w}; \
            const bf16x8 zb0 = __builtin_bit_cast(bf16x8, z0), zb1 = __builtin_bit_cast(bf16x8, z1); \
            _Pragma("unroll") for (int jt = 0; jt < 4; ++jt) { f32x4 nv = {bf2f((bf16)(qw[2 * jt] & 0xffff)), bf2f((bf16)(qw[2 * jt] >> 16)), bf2f((bf16)(qw[2 * jt + 1] & 0xffff)), bf2f((bf16)(qw[2 * jt + 1] >> 16))}; \
                nv = MFMA16(P[jt][0], zb0, nv); nv = MFMA16(P[jt][1], zb1, nv); acc[jt] = nv; } \
            } while (0)
        RBC_READ(pa, qa, 0);
        for (int st = 0; st < nc; st += 2) { RBC_STEP(pa, qa, pb, qb, st); RBC_STEP(pb, qb, pa, qa, st + 1); }
#undef RBC_READ
#undef RBC_STEP
    } else if (w >= 1 && w <= 5) {
        const bool pl = w <= 4;
        const bf16* src = pl ? Pg + (16 * (w - 1) + fr) * 64 + 8 * fq : Qg + i * 64 + 16 * fq;
        const int src2 = pl ? 32 : 8;
        const int ldst = pl ? ((w - 1) * 2) * 1024 + lane * 16 : 8192 + lane * 16;
        v4u pipe[DL][2];
#pragma unroll
        for (int k = 0; k < DL; ++k) { const long o = off0 + (long)k * dstep; pipe[k][0] = *(const GAS v4u*)(src + o); pipe[k][1] = *(const GAS v4u*)(src + o + src2); }
#pragma unroll
        for (int k = 0; k < 2; ++k) {
            *(LAS v4u*)(B0 + k * BUFB + ldst) = pipe[k][0]; *(LAS v4u*)(B0 + k * BUFB + ldst + 1024) = pipe[k][1];
            const long o = off0 + (long)(DL + k) * dstep; pipe[k][0] = *(const GAS v4u*)(src + o); pipe[k][1] = *(const GAS v4u*)(src + o + src2); }
        __syncthreads();
        for (int st0 = 0; st0 < nc; st0 += DL) {
#pragma unroll
            for (int k = 0; k < DL; ++k) { const int st = st0 + k, kk = (k + 2) % DL; LAS unsigned char* Bn = B0 + ((st + 2) % 3) * BUFB;
                *(LAS v4u*)(Bn + ldst) = pipe[kk][0]; *(LAS v4u*)(Bn + ldst + 1024) = pipe[kk][1];
                const int sn = st + 2 + DL < nc ? st + 2 + DL : nc - 1; const long o = off0 + (long)sn * dstep;
                pipe[kk][0] = *(const GAS v4u*)(src + o); pipe[kk][1] = *(const GAS v4u*)(src + o + src2);
                RBC_BAR(); }
        }
    } else if (w == 6) {
        __syncthreads();
        for (int st = 0; st < nc; ++st) {
            if (st > 0) { const LAS unsigned char* Sp = B0 + S0OFF + ((st - 1) & 1) * 2048; const long o = off0 + (long)(st - 1) * dstep;
                *(GAS v4u*)(Sg + i * 64 + 16 * fq + o) = *(const LAS v4u*)(Sp + lane * 16); *(GAS v4u*)(Sg + i * 64 + 16 * fq + o + 8) = *(const LAS v4u*)(Sp + 1024 + lane * 16); }
            RBC_BAR();
        }
        { const long o = off0 + (long)(nc - 1) * dstep; const LAS unsigned char* Sp = B0 + S0OFF + ((nc - 1) & 1) * 2048;
            *(GAS v4u*)(Sg + i * 64 + 16 * fq + o) = *(const LAS v4u*)(Sp + lane * 16); *(GAS v4u*)(Sg + i * 64 + 16 * fq + o + 8) = *(const LAS v4u*)(Sp + 1024 + lane * 16); }
    } else {
        const int lc = F.bid * 64 + lane;
        const f32x2* HLOC = (const f32x2*)(a.ws + WS_HLOC); f32x2* HIN = (f32x2*)(a.ws + WS_HIN); const float* S5C = (const float*)(a.ws + WS_S5C);
        const int b5 = lc >> 12, dgp = lc & 4095, dg = dgp >> 6, p5 = dgp & 63, d5 = dg >> 5, u05 = seq_row0(CTX_B + b5) / 64;
        const float l64r = S5C[(size_t)dg * 384 + 256 + p5], l64i = S5C[(size_t)dg * 384 + 320 + p5];
        float hr = a.in[I_SRE][(size_t)b5 * 4096 + dgp], hi = a.in[I_SIM][(size_t)b5 * 4096 + dgp];
        const f32x2* hl = HLOC + ((size_t)u05 * 64 + dg) * 64 + p5; f32x2* hn = HIN + ((size_t)u05 * 64 + dg) * 64 + p5;
        f32x2 e5[nc];
#pragma unroll
        for (int j = 0; j < nc; ++j) { const int c = d5 ? nc - 1 - j : j; e5[j] = hl[(size_t)c * 4096]; }
        __syncthreads();
#pragma unroll
        for (int st = 0; st < nc; ++st) { const int c = d5 ? nc - 1 - st : st; hn[(size_t)c * 4096] = (f32x2){hr, hi};
            const float nr = __builtin_fmaf(l64r, hr, __builtin_fmaf(-l64i, hi, e5[st].x)), ni = __builtin_fmaf(l64i, hr, __builtin_fmaf(l64r, hi, e5[st].y)); hr = nr; hi = ni;
            RBC_BAR(); }
    }
#undef RBC_BAR
}

constexpr int RC_WROW = 272, RC_WHEAD = 64 * RC_WROW + 512, RC_LDS0 = NWAVES * 8704;
static_assert(RC_LDS0 + 2 * RC_WHEAD <= LDSCTL_OFF, "R-C LDS map");
__device__ __forceinline__ void rc_stage(const Frame& F, const Args& a, int h0) {
    const bf16* Wg = (const bf16*)(a.ws + WS_WGU);
    { v4u tv[4];
#pragma unroll
        for (int q = 0; q < 4; ++q) { const int i = F.tid + q * NTHR, hh = i >> 10, row = (i >> 4) & 63, c8 = i & 15; tv[q] = *(const GAS v4u*)(Wg + (size_t)(64 * (h0 + hh) + row) * GLORA + 8 * c8); }
#pragma unroll
        for (int q = 0; q < 4; ++q) { const int i = F.tid + q * NTHR, hh = i >> 10, row = (i >> 4) & 63, c8 = i & 15; *(LAS v4u*)(F.lds + RC_LDS0 + hh * RC_WHEAD + row * RC_WROW + c8 * 16) = tv[q]; } }
    if (F.tid < 256) { const int hh = F.tid >> 7, j = F.tid & 127; const float v = j < 64 ? a.in[I_LNXG][64 * (h0 + hh) + j] : a.in[I_LNXB][64 * (h0 + hh) + j - 64];
        *(LAS float*)(F.lds + RC_LDS0 + hh * RC_WHEAD + 64 * RC_WROW + j * 4) = v; }
}
struct RcPre { bf16x8 sf[4], gA[2][2], sA[2][4][2]; v4u yl[2][2], vw[2]; float bsum; };
template <bool WITH_S = true>
__device__ __forceinline__ void rc_load(const Frame& F, const Args& a, int unit, int h, int tt, RcPre& P) {
    const int lane = F.lane, fr = lane & 15, fq = lane >> 4, t = 16 * tt + fr;
    const int chr = 16 * (fr >> 2) + (fr & 3);
    const bf16* Z = (const bf16*)(a.ws + WS_Z); const bf16* zr = Z + (size_t)(unit * 64 + t) * DZ;
#pragma unroll
    for (int ks = 0; ks < 4; ++ks) P.sf[ks] = __builtin_bit_cast(bf16x8, *(const GAS v4u*)(zr + OFF_GD + 32 * ks + 8 * fq));
#pragma unroll
    for (int dir = 0; dir < 2; ++dir) {
        const size_t cu = ((size_t)unit * NH + h) * 2 + dir; const int pos = dir ? 63 - t : t;
        const bf16* Sg = (const bf16*)(a.ws + WS_RS) + cu * 4096; const bf16* Gg = (const bf16*)(a.ws + WS_RG) + cu * 4096; const bf16* Yg = (const bf16*)(a.ws + WS_RY) + cu * 4096;
        P.gA[dir][0] = *(const bf16x8*)(Gg + pos * 64 + 8 * fq); P.gA[dir][1] = *(const bf16x8*)(Gg + pos * 64 + 32 + 8 * fq);
#pragma unroll
        for (int it = 0; it < 4; ++it) { if (!WITH_S) continue; P.sA[dir][it][0] = *(const bf16x8*)(Sg + (chr + 4 * it) * 64 + 8 * fq); P.sA[dir][it][1] = *(const bf16x8*)(Sg + (chr + 4 * it) * 64 + 32 + 8 * fq); }
        P.yl[dir][0] = *(const GAS v4u*)(Yg + pos * 64 + 16 * fq); P.yl[dir][1] = *(const GAS v4u*)(Yg + pos * 64 + 16 * fq + 8);
    }
    P.vw[0] = *(const GAS v4u*)(zr + OFF_V + 64 * h + 16 * fq); P.vw[1] = *(const GAS v4u*)(zr + OFF_V + 64 * h + 16 * fq + 8);
    P.bsum = ((const float*)(a.ws + WS_BONUS))[(size_t)(unit * 64 + t) * NH + h];
}
__device__ __forceinline__ void rc_compute(const Frame& F, const Args& a, int unit, int h, int tt, const RcPre& P, int img) {
    const int lane = F.lane, fr = lane & 15, fq = lane >> 4, t = 16 * tt + fr;
    const int chr = 16 * (fr >> 2) + (fr & 3);
    const LAS unsigned char* wl = F.lds + RC_LDS0 + img * RC_WHEAD;
    bf16* MIX = (bf16*)(a.ws + WS_MIX);
    f32x4 y[4], g[4];
#pragma unroll
    for (int it = 0; it < 4; ++it) { y[it] = (f32x4){0.f, 0.f, 0.f, 0.f}; g[it] = y[it]; }
#pragma unroll
    for (int dir = 0; dir < 2; ++dir)
#pragma unroll
        for (int it = 0; it < 4; ++it) {
            y[it] = MFMA16(P.sA[dir][it][0], P.gA[dir][0], y[it]); y[it] = MFMA16(P.sA[dir][it][1], P.gA[dir][1], y[it]);
            const unsigned w0 = P.yl[dir][it >> 1][2 * (it & 1)], w1 = P.yl[dir][it >> 1][2 * (it & 1) + 1];
            y[it] = y[it] + (f32x4){bf2f((bf16)(w0 & 0xffff)), bf2f((bf16)(w0 >> 16)), bf2f((bf16)(w1 & 0xffff)), bf2f((bf16)(w1 >> 16))}; }
#pragma unroll
    for (int it = 0; it < 4; ++it)
#pragma unroll
        for (int ks = 0; ks < 4; ++ks) g[it] = MFMA16(*(const LAS bf16x8*)(wl + (chr + 4 * it) * RC_WROW + (32 * ks + 8 * fq) * 2), P.sf[ks], g[it]);
    float s1 = 0.f, s2 = 0.f;
#pragma unroll
    for (int it = 0; it < 4; ++it) {
        s1 += (y[it][0] + y[it][1]) + (y[it][2] + y[it][3]); s2 += (y[it][0] * y[it][0] + y[it][1] * y[it][1]) + (y[it][2] * y[it][2] + y[it][3] * y[it][3]); }
    s1 += __shfl_xor(s1, 16); s1 += __shfl_xor(s1, 32); s2 += __shfl_xor(s2, 16); s2 += __shfl_xor(s2, 32);
    const float mu = s1 * (1.f / 64.f), var = fmaxf(s2 * (1.f / 64.f) - mu * mu, 0.f), rs = rsqrtf(var + 64e-5f);
    unsigned ow[8];
#pragma unroll
    for (int it = 0; it < 4; ++it) {
        const unsigned v0 = P.vw[it >> 1][2 * (it & 1)], v1 = P.vw[it >> 1][2 * (it & 1) + 1];
        const f32x4 vv = {bf2f((bf16)(v0 & 0xffff)), bf2f((bf16)(v0 >> 16)), bf2f((bf16)(v1 & 0xffff)), bf2f((bf16)(v1 >> 16))};
        f32x4 o;
        const f32x4 lg = *(const LAS f32x4*)(wl + 64 * RC_WROW + (16 * fq + 4 * it) * 4), lb = *(const LAS f32x4*)(wl + 64 * RC_WROW + 256 + (16 * fq + 4 * it) * 4);
#pragma unroll
        for (int r = 0; r < 4; ++r) o[r] = ((y[it][r] - mu) * rs * lg[r] + lb[r] + P.bsum * vv[r]) * g[it][r];
        ow[2 * it] = pk2(o[0], o[1]); ow[2 * it + 1] = pk2(o[2], o[3]); }
    bf16* mo = MIX + (size_t)(unit * 64 + t) * D + 64 * h + 16 * fq;
    *(GAS v4u*)mo = (v4u){ow[0], ow[1], ow[2], ow[3]}; *(GAS v4u*)(mo + 8) = (v4u){ow[4], ow[5], ow[6], ow[7]};
}
constexpr int RC_GSYNC = S5T_LDS0 + 2 * S5T_DIR, RC_SROW = 144, RC_SDIR = 64 * RC_SROW;
static_assert(RC_GSYNC + 128 <= LDSCTL_OFF && 2 * RC_SDIR <= 4 * 8704, "R-C group LDS map");
__device__ __forceinline__ void grp_sync(const Frame& F, int& epoch) {
    LAS int* c = (LAS int*)(F.lds + RC_GSYNC + (F.wave >> 2) * 64);
    epoch += 4;
    asm volatile("s_waitcnt lgkmcnt(0)" ::: "memory");
    if (F.lane == 0) __hip_atomic_fetch_add(c, 1, __ATOMIC_RELAXED, __HIP_MEMORY_SCOPE_WORKGROUP);
    while (__hip_atomic_load(c, __ATOMIC_RELAXED, __HIP_MEMORY_SCOPE_WORKGROUP) < epoch) __builtin_amdgcn_s_sleep(1);
    asm volatile("" ::: "memory");
}
__device__ __forceinline__ void rc_tasks(const Frame& F, const Args& a) {
    const int N = NUNIT * NH * 4, stride = F.G * NWAVES; int epoch = 0;
    const int lane = F.lane, fr = lane & 15, fq = lane >> 4, chr = 16 * (fr >> 2) + (fr & 3), q = F.wave & 3;
    LAS unsigned char* sb = F.lds + (F.wave >> 2) * (4 * 8704);
    for (int i = (M_CTX / 64) * NH * 4 + F.bid * NWAVES + F.wave; i < N; i += stride) {
        const int unit = i >> 5, h = (i >> 2) & 7;
        v4u sq[2][2];
#pragma unroll
        for (int dir = 0; dir < 2; ++dir) { const bf16* Sg = (const bf16*)(a.ws + WS_RS) + (((size_t)unit * NH + h) * 2 + dir) * 4096;
#pragma unroll
            for (int j = 0; j < 2; ++j) sq[dir][j] = *(const GAS v4u*)(Sg + (16 * q + 8 * j + (lane >> 3)) * 64 + 8 * (lane & 7)); }
        RcPre P0; rc_load<false>(F, a, unit, h, i & 3, P0);
        grp_sync(F, epoch);
#pragma unroll
        for (int dir = 0; dir < 2; ++dir)
#pragma unroll
            for (int j = 0; j < 2; ++j) *(LAS v4u*)(sb + dir * RC_SDIR + (16 * q + 8 * j + (lane >> 3)) * RC_SROW + 16 * (lane & 7)) = sq[dir][j];
        grp_sync(F, epoch);
#pragma unroll
        for (int dir = 0; dir < 2; ++dir)
#pragma unroll
            for (int it = 0; it < 4; ++it) { P0.sA[dir][it][0] = *(const LAS bf16x8*)(sb + dir * RC_SDIR + (chr + 4 * it) * RC_SROW + 16 * fq); P0.sA[dir][it][1] = *(const LAS bf16x8*)(sb + dir * RC_SDIR + (chr + 4 * it) * RC_SROW + 64 + 16 * fq); }
        asm volatile("" ::: "memory");
        rc_compute(F, a, unit, h, i & 3, P0, F.wave >> 2);
    }
    grp_sync(F, epoch);
}
__device__ __forceinline__ void rc_stage1(const Frame& F, const Args& a, int h) {
    const bf16* Wg = (const bf16*)(a.ws + WS_WGU);
    v4u tv[2];
#pragma unroll
    for (int q = 0; q < 2; ++q) { const int i = F.tid + q * NTHR, row = (i >> 4) & 63, c8 = i & 15; tv[q] = *(const GAS v4u*)(Wg + (size_t)(64 * h + row) * GLORA + 8 * c8); }
#pragma unroll
    for (int q = 0; q < 2; ++q) { const int i = F.tid + q * NTHR, row = (i >> 4) & 63, c8 = i & 15; *(LAS v4u*)(F.lds + RC_LDS0 + row * RC_WROW + c8 * 16) = tv[q]; }
    if (F.tid < 128) { const int j = F.tid; const float v = j < 64 ? a.in[I_LNXG][64 * h + j] : a.in[I_LNXB][64 * h + j - 64];
        *(LAS float*)(F.lds + RC_LDS0 + 64 * RC_WROW + j * 4) = v; }
}

__device__ __forceinline__ void tr_item(const float* W, int ldw, int K, int col0, bf16* WT, int row_off, LAS float* scr, int kb, int nb, int lane) {
    const int k0 = 64 * kb, n0 = 32 * nb;
    { f32x4 v[8]; const float* wp = W + (size_t)(k0 + (lane >> 3)) * ldw + col0 + n0 + 4 * (lane & 7);
#pragma unroll
        for (int i = 0; i < 8; ++i) v[i] = *(const GAS f32x4*)(wp + (size_t)(8 * i) * ldw);
#pragma unroll
        for (int i = 0; i < 8; ++i) { LAS float* d = scr + (8 * i + (lane >> 3)) * 33 + 4 * (lane & 7); d[0] = v[i][0]; d[1] = v[i][1]; d[2] = v[i][2]; d[3] = v[i][3]; } }
    LDS_WAIT(); asm volatile("" ::: "memory");
    const int c = lane & 7;
#pragma unroll
    for (int j = 0; j < 4; ++j) { const int n = (lane >> 3) + 8 * j; const LAS float* s = scr + (8 * c) * 33 + n;
        v4u o; o.x = pk2(s[0 * 33], s[1 * 33]); o.y = pk2(s[2 * 33], s[3 * 33]); o.z = pk2(s[4 * 33], s[5 * 33]); o.w = pk2(s[6 * 33], s[7 * 33]);
        *(GAS v4u*)(WT + (size_t)(row_off + n0 + n) * K + k0 + 8 * c) = o; }
    LDS_WAIT(); asm volatile("" ::: "memory");
}
__device__ __forceinline__ void ffn_weight_copies(const Frame& F, const Args& a, int first, int count) {
    LAS float* scr = (LAS float*)(F.lds + F.wave * 16384);
    constexpr int I_F1 = 16 * 128, I_F2 = 64 * 32;
    for (int it = first; it < first + count && it < I_F1 + I_F2; ++it) {
        if (it < I_F1) tr_item(a.in[I_WFF1], DFF, D, 0, (bf16*)(a.ws + WS_WFF1), 0, scr, it / 128, it % 128, F.lane);
        else { const int r = it - I_F1; tr_item(a.in[I_WFF2], D, DFF, 0, (bf16*)(a.ws + WS_WFF2), 0, scr, r / 32, r % 32, F.lane); }
    }
}
__device__ __forceinline__ void p0_prologue(const Frame& F, const Args& a) {
    unsigned char* ws = a.ws;
    LAS float* scr = (LAS float*)(F.lds + F.wave * 16384);
    constexpr int KQ = 8, NMODWG = (MODW / 256) * KQ;
    const bool split = F.G > NMODWG;
    if (!split || F.bid < NMODWG) {
        LAS float* sil = (LAS float*)F.lds;
        LAS float* part = (LAS float*)(F.lds + 16384);
        LAS unsigned* lastf = (LAS unsigned*)(F.lds + 16384 + 8 * 3 * 256 * 4);
        float* PART = (float*)(ws + WS_MODPART); unsigned* cnt = (unsigned*)(ws + WS_CTL) + CW_MOD;
        { float cv[6];
#pragma unroll
            for (int q = 0; q < 6; ++q) { const int i = F.tid + q * NTHR, ci = i >> 10, k = i & 1023; cv[q] = ci == 0 ? a.in[I_CCTX][k] : a.in[I_C][(ci - 1) * D + k]; }
#pragma unroll
            for (int q = 0; q < 6; ++q) sil[F.tid + q * NTHR] = cv[q] * sigmoidf_(cv[q]); }
        __syncthreads();
        for (int item = F.bid; item < NMODWG; item += F.G) {
            const int cb = item / KQ, kq = item % KQ, r0 = (1024 / KQ) * kq + 16 * F.wave;
            const float* wp = a.in[I_WADA] + (size_t)r0 * MODW + 256 * cb + 4 * F.lane;
            f32x4 wv[16], a0 = {0.f, 0.f, 0.f, 0.f}, a1 = a0, a2 = a0;
#pragma unroll
            for (int j = 0; j < 16; ++j) wv[j] = *(const GAS f32x4*)(wp + (size_t)j * MODW);
#pragma unroll
            for (int j = 0; j < 16; ++j) { a0 += sil[r0 + j] * wv[j]; a1 += sil[1024 + r0 + j] * wv[j]; a2 += sil[2048 + r0 + j] * wv[j]; }
            *(LAS f32x4*)(part + (F.wave * 3 + 0) * 256 + 4 * F.lane) = a0; *(LAS f32x4*)(part + (F.wave * 3 + 1) * 256 + 4 * F.lane) = a1; *(LAS f32x4*)(part + (F.wave * 3 + 2) * 256 + 4 * F.lane) = a2;
            __syncthreads();
            for (int t = F.tid; t < 768; t += NTHR) { const int ci = t >> 8, l = t & 255; float sm = 0.f;
#pragma unroll
                for (int w = 0; w < 8; ++w) sm += part[(w * 3 + ci) * 256 + l];
                __hip_atomic_store((unsigned*)(PART + ((size_t)kq * 3 + ci) * MODW + 256 * cb + l), __builtin_bit_cast(unsigned, sm), __ATOMIC_RELAXED, __HIP_MEMORY_SCOPE_AGENT); }
            asm volatile("s_waitcnt vmcnt(0)" ::: "memory");
            __syncthreads();
            if (F.tid == 0) { const unsigned old = __hip_atomic_fetch_add(cnt + cb, 1u, __ATOMIC_RELAXED, __HIP_MEMORY_SCOPE_AGENT); *lastf = (old % KQ) == KQ - 1 ? 1u : 0u; }
            __syncthreads();
            if (*lastf) {
                __builtin_amdgcn_fence(__ATOMIC_ACQUIRE, "agent");
                for (int t = F.tid; t < 768; t += NTHR) { const int ci = t >> 8, l = t & 255; float sm = a.in[I_BADA][256 * cb + l];
#pragma unroll
                    for (int q = 0; q < KQ; ++q) sm += __builtin_bit_cast(float, __hip_atomic_load((unsigned*)(PART + ((size_t)q * 3 + ci) * MODW + 256 * cb + l), __ATOMIC_RELAXED, __HIP_MEMORY_SCOPE_AGENT));
                    ((float*)(ws + WS_MOD))[ci * MODW + 256 * cb + l] = sm; }
            }
            __syncthreads();
        }
    }
    const int NGW = F.G * NWAVES;
    const int gw = split ? (F.bid >= NMODWG ? (F.bid - NMODWG) * NWAVES + F.wave : (F.G - NMODWG) * NWAVES + F.bid * NWAVES + F.wave) : F.bid * NWAVES + F.wave;
    constexpr int I_IN1 = 16 * 60, I_IN2 = 16 * 16, I_OUT = 16 * 32, I_GL = 8 * 16;
    constexpr int NITEMS = I_IN1 + I_IN2 + I_OUT + I_GL;
    for (int it = gw; it < NITEMS; it += NGW) {
        int r = it;
        if (r < I_IN1) { tr_item(a.in[I_WIN], DZW, D, 0, (bf16*)(ws + WS_WIN), 0, scr, r / 60, r % 60, F.lane); continue; } r -= I_IN1;
        if (r < I_IN2) { tr_item(a.in[I_WIN], DZW, D, 1920, (bf16*)(ws + WS_WIN), 2048, scr, r / 16, r % 16, F.lane); continue; } r -= I_IN2;
        if (r < I_OUT) { tr_item(a.in[I_WOUT], D, D, 0, (bf16*)(ws + WS_WOUT), 0, scr, r / 32, r % 32, F.lane); continue; } r -= I_OUT;
        tr_item(a.in[I_WGLU], DS, DS, 0, (bf16*)(ws + WS_WGLU), 0, scr, r / 16, r % 16, F.lane);
    }
    const int tb = split ? F.bid - NMODWG : F.bid, TG = split ? F.G - NMODWG : F.G;
    if (tb >= 0) {
        for (int i = tb * NTHR + F.tid; i < 128 * 1024 / 8; i += TG * NTHR) ((GAS v4u*)(ws + WS_WIN + (size_t)1920 * D * 2))[i] = (v4u){0u, 0u, 0u, 0u};
        for (int i = tb * NTHR + F.tid; i < 64 * 512; i += TG * NTHR) {
            const int r = i >> 9, dd = i & 511, f = dd & 255; const float omega = 1.0f / powf(10000.0f, (float)f * (1.0f / 256.0f)); const float ang = (float)r * omega;
            ((float*)(ws + WS_PE))[i] = dd < 256 ? sinf(ang) : cosf(ang);
        }
        p0_s5_tables(F, a, tb, TG);
        p0_lora(F, a, tb, TG);
    }
}

__device__ __forceinline__ void p1_rows(const Frame& F, const Args& a) {
    const int gw = F.bid * NWAVES + F.wave, NGW = F.G * NWAVES;
    const float* pe = (const float*)(a.ws + WS_PE); const float* modb = (const float*)(a.ws + WS_MOD); bf16* XN = (bf16*)(a.ws + WS_XN);
    const bool pe_fixed = (NGW & 63) == 0; f32x4 pe2[2];
#pragma unroll
    for (int jj = 0; jj < 2; ++jj) pe2[jj] = ((const GAS f32x4*)(pe + (gw & 63) * 512 + jj * 256))[F.lane];
    if (M == 6 * NGW && pe_fixed) {
        f32x4 v[6][4], pv[4][2];
#pragma unroll
        for (int k = 0; k < 6; ++k) { const int m = gw + k * NGW; const float* src = m < M_CTX ? a.in[I_XP] + (size_t)m * D : a.in[I_XS] + (size_t)(m - M_CTX) * D;
#pragma unroll
            for (int j = 0; j < 4; ++j) v[k][j] = ((const GAS f32x4*)src)[F.lane + 64 * j];
            if (k >= 2) { const int n = (m - M_CTX) & (LAT_T - 1);
#pragma unroll
                for (int j = 0; j < 2; ++j) pv[k - 2][j] = ((const GAS f32x4*)(pe + (n >> 6) * 512 + j * 256))[F.lane]; } }
        asm volatile("" ::: "memory");
#pragma unroll
        for (int kp = 0; kp < 3; ++kp) {
            f32x4 ga[4], sb[4]; const float* mod = modb + kp * MODW;
#pragma unroll
            for (int j = 0; j < 4; ++j) { const f32x4 g = ((const GAS f32x4*)a.in[I_N1G])[F.lane + 64 * j], sc = ((const GAS f32x4*)(mod + 1 * D))[F.lane + 64 * j]; sb[j] = ((const GAS f32x4*)(mod + 0 * D))[F.lane + 64 * j]; ga[j] = g * (sc + 1.f); }
#pragma unroll
            for (int q = 0; q < 2; ++q) { const int k = 2 * kp + q, m = gw + k * NGW; float ss = 0.f;
#pragma unroll
                for (int j = 0; j < 4; ++j) { if (k >= 2) v[k][j] = v[k][j] + (j < 2 ? pv[k - 2][j] : pe2[j & 1]);
                    ss += (v[k][j].x * v[k][j].x + v[k][j].y * v[k][j].y) + (v[k][j].z * v[k][j].z + v[k][j].w * v[k][j].w); }
                const float rs = rsqrtf(wave_sum(ss) * (1.f / D) + 1e-6f);
#pragma unroll
                for (int j = 0; j < 4; ++j) { const f32x4 h = v[k][j] * rs * ga[j] + sb[j];
                    ((GAS unsigned long long*)(XN + (size_t)m * D))[F.lane + 64 * j] = (unsigned long long)pk2(h.x, h.y) | ((unsigned long long)pk2(h.z, h.w) << 32); } }
        }
        return;
    }
    for (int m0 = gw; m0 < M; m0 += 2 * NGW) {
        f32x4 v[2][4]; float ss[2] = {0.f, 0.f}; int mm[2]; mm[0] = m0; mm[1] = m0 + NGW < M ? m0 + NGW : m0;
#pragma unroll
        for (int q = 0; q < 2; ++q) { const int m = mm[q];
            const float* src = m < M_CTX ? a.in[I_XP] + (size_t)m * D : a.in[I_XS] + (size_t)(m - M_CTX) * D;
#pragma unroll
            for (int j = 0; j < 4; ++j) { v[q][j] = ((const GAS f32x4*)src)[F.lane + 64 * j];
                if (m >= M_CTX) { const int n = (m - M_CTX) & (LAT_T - 1);
                    if (j < 2 || !pe_fixed) { const int i = j < 2 ? (n >> 6) : (n & 63); const f32x4 pv = ((const GAS f32x4*)(pe + i * 512 + (j & 1) * 256))[F.lane]; v[q][j] = v[q][j] + pv; }
                    else v[q][j] = v[q][j] + pe2[j & 1]; }
                ss[q] += (v[q][j].x * v[q][j].x + v[q][j].y * v[q][j].y) + (v[q][j].z * v[q][j].z + v[q][j].w * v[q][j].w); } }
        const bool same = row_cond(mm[0]) == row_cond(mm[1]);
        f32x4 ga[4], sb[4];
        { const float* mod = modb + row_cond(mm[0]) * MODW;
#pragma unroll
            for (int j = 0; j < 4; ++j) { const f32x4 g = ((const GAS f32x4*)a.in[I_N1G])[F.lane + 64 * j], sc = ((const GAS f32x4*)(mod + 1 * D))[F.lane + 64 * j]; sb[j] = ((const GAS f32x4*)(mod + 0 * D))[F.lane + 64 * j]; ga[j] = g * (sc + 1.f); } }
#pragma unroll
        for (int q = 0; q < 2; ++q) { const int m = mm[q]; if (q == 1 && m == m0) break;
            if (q == 1 && !same) { const float* mod = modb + row_cond(m) * MODW;
#pragma unroll
                for (int j = 0; j < 4; ++j) { const f32x4 g = ((const GAS f32x4*)a.in[I_N1G])[F.lane + 64 * j], sc = ((const GAS f32x4*)(mod + 1 * D))[F.lane + 64 * j]; sb[j] = ((const GAS f32x4*)(mod + 0 * D))[F.lane + 64 * j]; ga[j] = g * (sc + 1.f); } }
            const float rs = rsqrtf(wave_sum(ss[q]) * (1.f / D) + 1e-6f);
#pragma unroll
            for (int j = 0; j < 4; ++j) {
                const f32x4 h = v[q][j] * rs * ga[j] + sb[j];
                ((GAS unsigned long long*)(XN + (size_t)m * D))[F.lane + 64 * j] = (unsigned long long)pk2(h.x, h.y) | ((unsigned long long)pk2(h.z, h.w) << 32);
            } }
    }
}
__device__ __forceinline__ void p8_rows(const Frame& F, const Args& a) {
    const int gw = F.bid * NWAVES + F.wave, NGW = F.G * NWAVES;
    const float* modb = (const float*)(a.ws + WS_MOD); bf16* XN = (bf16*)(a.ws + WS_XN);
    for (int m = gw; m < M; m += NGW) {
        const int ci = row_cond(m); const float* mod = modb + ci * MODW;
        f32x4 v[4]; float ss = 0.f;
#pragma unroll
        for (int j = 0; j < 4; ++j) { v[j] = ((const GAS f32x4*)(a.out + (size_t)m * D))[F.lane + 64 * j]; ss += (v[j].x * v[j].x + v[j].y * v[j].y) + (v[j].z * v[j].z + v[j].w * v[j].w); }
        const float rs = rsqrtf(wave_sum(ss) * (1.f / D) + 1e-6f);
#pragma unroll
        for (int j = 0; j < 4; ++j) {
            const f32x4 g = ((const GAS f32x4*)a.in[I_N2G])[F.lane + 64 * j], sc = ((const GAS f32x4*)(mod + 4 * D))[F.lane + 64 * j], sh = ((const GAS f32x4*)(mod + 3 * D))[F.lane + 64 * j];
            const f32x4 h = v[j] * rs * g * (sc + 1.f) + sh;
            ((GAS unsigned long long*)(XN + (size_t)m * D))[F.lane + 64 * j] = (unsigned long long)pk2(h.x, h.y) | ((unsigned long long)pk2(h.z, h.w) << 32);
        }
    }
}
__device__ __forceinline__ void p11_rows(const Frame& F, const Args& a) {
    const int gw = F.bid * NWAVES + F.wave, NGW = F.G * NWAVES;
    for (int m = gw; m < M; m += NGW) {
        f32x4 v[4]; float ss = 0.f;
#pragma unroll
        for (int j = 0; j < 4; ++j) { v[j] = ((const GAS f32x4*)(a.out + (size_t)m * D))[F.lane + 64 * j]; ss += (v[j].x * v[j].x + v[j].y * v[j].y) + (v[j].z * v[j].z + v[j].w * v[j].w); }
        const float rs = rsqrtf(wave_sum(ss) * (1.f / D) + 1e-6f);
#pragma unroll
        for (int j = 0; j < 4; ++j) { const f32x4 g = ((const GAS f32x4*)a.in[I_NFG])[F.lane + 64 * j]; ((GAS f32x4*)(a.out + (size_t)m * D))[F.lane + 64 * j] = v[j] * rs * g; }
    }
}


#define XB_TMO      128
#define XB_XCNT(j)  (256  + 64 * (j))
#define XB_XSUB(j)  (1280 + 64 * (j))
#define XB_XGEN(j)  (2304 + 64 * (j))
#define XB_TOP      3328
#define XB_TOPGEN   3392
#define XCD_BAR_WORDS 3456
#define XB_SPIN_CAP (1u << 18)

__device__ __forceinline__ unsigned xb_ld(unsigned* p)              { return __hip_atomic_load(p, __ATOMIC_RELAXED, __HIP_MEMORY_SCOPE_AGENT); }
__device__ __forceinline__ unsigned xb_add(unsigned* p, unsigned v) { return __hip_atomic_fetch_add(p, v, __ATOMIC_RELAXED, __HIP_MEMORY_SCOPE_AGENT); }
__device__ __forceinline__ unsigned xb_xcc_id() { return (unsigned)__builtin_amdgcn_s_getreg((3 << 11) | 20) & 0xFu; }
#define XB_SPIN(cond, bar) do { unsigned _sp = 0; while (cond) { __builtin_amdgcn_s_sleep(1); \
    if ((++_sp & 255u) == 0u) { if (xb_ld(&(bar)[XB_TMO])) break; if (_sp > XB_SPIN_CAP) { atomicAdd(&(bar)[XB_TMO], 1u); break; } } } } while (0)

struct XcdBarrier {
    unsigned* bar; unsigned x;
    volatile LAS unsigned* st;
};

__device__ __forceinline__ XcdBarrier xcd_barrier_post(unsigned* bar, volatile LAS unsigned* st) {
    XcdBarrier b; b.bar = bar; b.x = xb_xcc_id(); b.st = st;
    if (threadIdx.x == 0) (void)xb_add(&bar[XB_XCNT(b.x)], 1u);
    return b;
}
__device__ __forceinline__ void xcd_barrier_complete(unsigned* bar, unsigned x, unsigned& nloc, unsigned& nx) {
    const unsigned G = gridDim.x * gridDim.y * gridDim.z;
    unsigned sum, cnt, mine, sp = 0u;
    for (;;) {
        sum = 0u; cnt = 0u; mine = 0u;
#pragma unroll
        for (unsigned j = 0; j < 16; ++j) { const unsigned c = xb_ld(&bar[XB_XCNT(j)]); sum += c; cnt += (c > 0u) ? 1u : 0u; mine = (j == x) ? c : mine; }
        if (sum == G) break;
        __builtin_amdgcn_s_sleep(1);
        if ((++sp & 255u) == 0u) { if (xb_ld(&bar[XB_TMO])) break; if (sp > XB_SPIN_CAP) { atomicAdd(&bar[XB_TMO], 1u); break; } }
    }
    nloc = mine > 0u ? mine : 1u; nx = cnt > 0u ? cnt : 1u;
}

__device__ __forceinline__ void xcd_barrier(const XcdBarrier& b) {
    asm volatile("s_waitcnt vmcnt(0)" ::: "memory");
    __syncthreads();
    if (threadIdx.x == 0) {
        unsigned* bar = b.bar;
        __builtin_amdgcn_s_waitcnt(0);
        unsigned nloc = b.st[0], nx = b.st[1];
        if (nloc == 0u) { xcd_barrier_complete(bar, b.x, nloc, nx); b.st[0] = nloc; b.st[1] = nx; }
        const unsigned old = xb_add(&bar[XB_XSUB(b.x)], 1u);
        const unsigned gen = old / nloc;
        if (old + 1u == (gen + 1u) * nloc) {
            __builtin_amdgcn_fence(__ATOMIC_RELEASE, "agent");
            asm volatile("s_waitcnt vmcnt(0)" ::: "memory");
            const unsigned og = xb_add(&bar[XB_TOP], 1u);
            const unsigned tg = og / nx;
            if (og + 1u == (tg + 1u) * nx) xb_add(&bar[XB_TOPGEN], 1u);
        }
        XB_SPIN(xb_ld(&bar[XB_TOPGEN]) == gen, bar);
        __builtin_amdgcn_fence(__ATOMIC_ACQUIRE, "agent");
        asm volatile("s_waitcnt vmcnt(0)" ::: "memory");
    }
    __syncthreads();
}


__global__ void __launch_bounds__(NTHR, 2) mk_fwd(Args args) {
    extern __shared__ __attribute__((aligned(16))) unsigned char lds[];
    Frame F; F.lds = (LAS unsigned char*)lds; F.tid = threadIdx.x; F.lane = F.tid & 63; F.wave = __builtin_amdgcn_readfirstlane(F.tid >> 6); F.G = gridDim.x; F.bid = blockIdx.x;
    unsigned char* ws = args.ws;
    const int lo = args.ph_lo, hi = args.ph_hi;
    for (int u = F.tid; u < (LDS_BYTES - LDSCTL_OFF) / 4; u += NTHR) ((LAS unsigned*)(F.lds + LDSCTL_OFF))[u] = 0u;
    __syncthreads();
    XcdBarrier bar = xcd_barrier_post((unsigned*)(ws + WS_CTL) + CW_BAR, (volatile LAS unsigned*)(F.lds + MISC_OFF) + 8);
#define IN(k) (lo <= (k) && (k) < hi)
#define SEAM(k) do { if (IN(k) && IN((k) + 1)) xcd_barrier(bar); } while (0)
    if (IN(0)) p0_prologue(F, args);
    SEAM(0);
    if (IN(1)) p1_rows(F, args);
    SEAM(1);
    if (IN(2)) {
        pg8::Gemm g{(const bf16*)(ws + WS_XN), (const bf16*)(ws + WS_WIN), M, DZ, D}; pg8::StaticOrder S; S.init(M, DZ, F.G, F.bid);
        pg8::EpiStore E{(bf16*)(ws + WS_Z), DZ, 2};
        pg8::gemm_phase<pg8::EpiStore, pg8::StaticOrder, true, true>(F.lds, g, S, E);
        asm volatile("s_waitcnt vmcnt(0)" ::: "memory"); __syncthreads();
        s5_stage(F, args, F.bid & 31);
    }
    SEAM(2);
    if (IN(3)) {
        { const int g3 = F.bid & 31; S5Pre Pc; s5_load<false>(F, args, (F.bid >> 5) + 8 * F.wave, g3, Pc);
#pragma unroll 1
            for (int u = (F.bid >> 5) + 8 * F.wave; u < NUNIT; u += 64) { S5Pre Pn; s5_load<false>(F, args, u + 64 < NUNIT ? u + 64 : u, g3, Pn); asm volatile("" ::: "memory"); s5_unit<false>(F, args, u, g3, Pc); Pc.afrP[0][0] = Pn.afrP[0][0]; Pc.afrP[0][1] = Pn.afrP[0][1]; Pc.afrP[1][0] = Pn.afrP[1][0]; Pc.afrP[1][1] = Pn.afrP[1][1]; } }
        if ((F.G & 15) == 0 && (NUNIT * NH * 2) % (2 * F.G) == 0) {
            const int h = (F.bid >> 1) & 7, dir = F.bid & 1, u2 = F.wave >> 2;
            if (F.tid < 128) *(LAS float*)(F.lds + RA_KK_LDS + F.tid * 4) = F.tid < 64 ? args.in[I_KK][64 * h + F.tid] : args.in[I_RK][64 * h + F.tid - 64];
            { const int i0 = F.bid + F.G * u2; int tid_p = F.tid; asm volatile("" : "+v"(tid_p));
                Ra2Pre Pf; Ra2Frag Fg; ra2_prefetch(F, args, i0 >> 4, h, dir, Pf, tid_p); ra2_frags(F, args, i0 >> 4, dir, Fg, tid_p);
#pragma unroll 1
                for (int i = i0; i < NUNIT * NH * 2; i += 2 * F.G) ra2_unit(F, args, i >> 4, h, dir, Pf, Fg, i + 2 * F.G < NUNIT * NH * 2 ? (i + 2 * F.G) >> 4 : -1); }
        }
        __syncthreads();
        if (F.bid >= 128 && F.G == 256) rc_stage1(F, args, (F.bid - 128) & 7);
    }
    SEAM(3);
    if (IN(4)) {
        if (F.bid < 128) { const int k = (F.bid & 7) * 4 + (F.bid >> 5); rb_latent_coop(F, args, CTX_B + (k >> 4), (k >> 1) & 7, k & 1, (F.bid >> 3) & 3); }
        else if (F.G == 256) { const int slot = (F.bid - 128) * NWAVES + F.wave;
            const int cw = F.bid - 128, cs = cw >> 3, ch = cw & 7;
            { const int k = slot >> 2; rb_chain(F, args, k >> 4, (k >> 1) & 7, k & 1, slot & 3); }
            asm volatile("s_waitcnt vmcnt(0)" ::: "memory"); __syncthreads();
            { const int unit = 4 * cs + (F.wave >> 1);
#pragma unroll 1
                for (int q = 0; q < 2; ++q) { const int tt = 2 * (F.wave & 1) + q; RcPre P0; rc_load(F, args, unit, ch, tt, P0); asm volatile("" ::: "memory"); rc_compute(F, args, unit, ch, tt, P0, 0); } }
            s5_pass_ctx(F, args, slot * 64 + F.lane); }
        __syncthreads();
        if (F.tid < 2) *(LAS int*)(F.lds + RC_GSYNC + F.tid * 64) = 0;
        rc_stage(F, args, (2 * F.bid) & 7); s5_stage(F, args, F.bid & 31);
    }
    SEAM(4);
    if (IN(5)) {
#pragma unroll 1
        for (int ph = 0; ph < 2; ++ph) {
            if ((ph == 0) == (F.wave >= 4)) { for (int u = (F.bid >> 5) + 8 * F.wave; u < NUNIT; u += 64) { S5Pre P; s5_load<true>(F, args, u, F.bid & 31, P); asm volatile("" ::: "memory"); s5_unit<true>(F, args, u, F.bid & 31, P); } }
            else rc_tasks(F, args);
        }
    }
    SEAM(5);
    if (IN(6)) {
        constexpr int NG2 = (M / 128) * (DS / 256);
        if (F.bid < NG2) {
            pg8::Gemm g{(const bf16*)(ws + WS_YS), (const bf16*)(ws + WS_WGLU), M, DS, DS}; pg8::StaticOrder S; S.init(M, DS, F.G, F.bid, 128);
            pg8::EpiGlu<2> E{(bf16*)(ws + WS_MIX), (const bf16*)(ws + WS_YS), args.in[I_BGLU]};
            pg8::gemm_phase<pg8::EpiGlu<2>, pg8::StaticOrder, true, true, 2>(F.lds, g, S, E);
            __syncthreads();
            ffn_weight_copies(F, args, 5 * (F.G - NG2) * NWAVES + F.bid * NWAVES + F.wave, 1);
        } else ffn_weight_copies(F, args, 5 * ((F.bid - NG2) * NWAVES + F.wave), 5);
    }
    SEAM(6);
    if (IN(7)) {
        pg8::Gemm g{(const bf16*)(ws + WS_MIX), (const bf16*)(ws + WS_WOUT), M, D, D}; pg8::StaticOrder S; S.init(M, D, F.G, F.bid, 192);
        pg8::RowStat R{(unsigned*)(ws + WS_XS), (unsigned*)(ws + WS_CTL) + CW_RS};
        pg8::EpiResidNorm<false, 3> E{args.out, (const float*)(ws + WS_MOD), args.in[I_N2G], (bf16*)(ws + WS_XN), R, args.in[I_XP], args.in[I_XS], (const float*)(ws + WS_PE), (const float*)(ws + WS_WIN + (size_t)1920 * D * 2), (bf16*)(ws + WS_X1B)};
        pg8::gemm_phase<pg8::EpiResidNorm<false, 3>, pg8::StaticOrder, false, true, 3>(F.lds, g, S, E);
    }
    if (IN(7) && IN(9)) xcd_barrier(bar);
    if (IN(9)) {
        pg8::Gemm g{(const bf16*)(ws + WS_XN), (const bf16*)(ws + WS_WFF1), M, DFF, D}; pg8::StaticOrder S; S.init(M, DFF, F.G, F.bid);
        pg8::EpiStore E{(bf16*)(ws + WS_H), DFF, 1};
        pg8::gemm_phase<pg8::EpiStore, pg8::StaticOrder, true, true>(F.lds, g, S, E);
    }
    SEAM(9);
    if (IN(10)) {
        pg8::Gemm g{(const bf16*)(ws + WS_H), (const bf16*)(ws + WS_WFF2), M, D, DFF}; pg8::StaticOrder S; S.init(M, D, F.G, F.bid, 192);
        pg8::RowStat R{(unsigned*)(ws + WS_XS) + 65536, (unsigned*)(ws + WS_CTL) + CW_RS + 4096};
        pg8::EpiResidNorm<true, 3> E{args.out, (const float*)(ws + WS_MOD), args.in[I_NFG], nullptr, R, nullptr, nullptr, nullptr, nullptr, (bf16*)(ws + WS_X1B)};
        pg8::gemm_phase<pg8::EpiResidNorm<true, 3>, pg8::StaticOrder, false, true, 3>(F.lds, g, S, E);
    }
#undef IN
#undef SEAM
}

extern "C" void kernel_launch(void* const* d_in, const int* in_sizes, int n_in, void* d_out, int out_size, void* d_ws, size_t ws_size, hipStream_t stream) {
    static int grid = 0;
    if (grid == 0) {
        int dev = 0, cus = 0, per_cu = 0;
        (void)hipGetDevice(&dev); (void)hipDeviceGetAttribute(&cus, hipDeviceAttributeMultiprocessorCount, dev);
        (void)hipFuncSetAttribute((const void*)mk_fwd, hipFuncAttributeMaxDynamicSharedMemorySize, LDS_BYTES);
        (void)hipOccupancyMaxActiveBlocksPerMultiprocessor(&per_cu, (const void*)mk_fwd, NTHR, LDS_BYTES);
        if (per_cu < 1) { fprintf(stderr, "kernel_launch: occupancy query says %d blocks per CU\n", per_cu); per_cu = 1; }
        if (per_cu > 1) per_cu = 1;
        grid = cus * per_cu;
        if (ws_size < WS_END) { fprintf(stderr, "kernel_launch: workspace too small (%zu)\n", ws_size); }
        if (grid != 256) fprintf(stderr, "kernel_launch: this kernel's phase maps assume 256 resident workgroups (256 CUs); got %d\n", grid);
    }
    Args a{};
    for (int i = 0; i < 36; ++i) a.in[i] = (const float*)d_in[i];
    a.out = (float*)d_out; a.ws = (unsigned char*)d_ws;
    (void)hipMemsetAsync((char*)d_ws + WS_CTL, 0, CTL_MEMSET_BYTES, stream);
    a.ph_lo = 0; a.ph_hi = 12;
    void* kargs[] = {&a};
    const hipError_t le = hipLaunchCooperativeKernel((const void*)mk_fwd, dim3(grid), dim3(NTHR), kargs, LDS_BYTES, stream);
    if (le != hipSuccess) fprintf(stderr, "kernel_launch: cooperative launch failed: %s (grid %d)\n", hipGetErrorString(le), grid);
}
```
